# Optimizing an MI355X kernel written in HIP

```python
import math
import jax, jax.numpy as jnp
from jax import lax
import numpy as np

D_MODEL = 1024
BATCH = 8
SEQ = 2048
DEPTH = 4
DEC_BATCH = 128
DEC_SEQ = 8
PAST_LEN = 8192
PAGE_SIZE = 128

ATTN_HEADS = 8
KV_HEADS = 2
HEAD_DIM = 64
Q_PER_KV = ATTN_HEADS // KV_HEADS
ATTN_WIDTH = ATTN_HEADS * HEAD_DIM
KV_WIDTH = KV_HEADS * HEAD_DIM
WINDOW = 128
ROPE_THETA = 10000.0
HG_HEADS = 4
HG_DK = 128
HG_DV = 128
HG_KW = HG_HEADS * HG_DK
HG_VW = HG_HEADS * HG_DV
HG_CHUNK = 64
MIX_WIDTH = ATTN_WIDTH + HG_VW
IN_COLS = 2 * ATTN_WIDTH + 2 * KV_WIDTH + 2 * HG_KW + 2 * HG_VW
PLE_DIM = 256
DN_ALPHA = (2 * DEPTH) ** 0.25
DN_BETA = (8 * DEPTH) ** -0.25
NORM_EPS = 1e-5
NEG_INF = -1e30

kernel_name = 'hymba_swa_sink_hgrn2_deepnorm_decode_step'


def _split_points():
    sizes = [ATTN_WIDTH, KV_WIDTH, KV_WIDTH, ATTN_WIDTH, HG_KW, HG_KW, HG_VW, HG_VW]
    return [int(s) for s in np.cumsum(sizes)[:-1]]


def _rmsnorm(x, g):
    xf = x.astype(jnp.float32)
    return xf * lax.rsqrt(jnp.mean(xf * xf, axis=-1, keepdims=True) + NORM_EPS) * g.astype(jnp.float32)


def _layernorm(x, g, b):
    xf = x.astype(jnp.float32)
    mu = jnp.mean(xf, axis=-1, keepdims=True)
    var = jnp.mean(jnp.square(xf - mu), axis=-1, keepdims=True)
    return (xf - mu) * lax.rsqrt(var + NORM_EPS) * g.astype(jnp.float32) + b.astype(jnp.float32)


def _rope(x, pos):
    dh = x.shape[-1]
    half = dh // 2
    inv = jnp.exp(-math.log(ROPE_THETA) * jnp.arange(half, dtype=jnp.float32) * 2.0 / dh)
    ang = pos.astype(jnp.float32)[:, None] * inv[None, :]
    cos = jnp.cos(ang)[:, None, :]
    sin = jnp.sin(ang)[:, None, :]
    xf = x.astype(jnp.float32)
    x1, x2 = xf[..., :half], xf[..., half:]
    return jnp.concatenate([x1 * cos - x2 * sin, x2 * cos + x1 * sin], axis=-1)


def _sink_window_attend(q, k, v, qpos, kpos, sinks):
    scale = HEAD_DIM ** -0.5
    s = jnp.einsum('bnqhgd,bnkhd->bnhgqk', q.astype(jnp.float32), k.astype(jnp.float32)) * scale
    diff = qpos[:, :, None] - kpos[:, None, :]
    valid = (diff >= 0) & (diff < WINDOW) & (kpos[:, None, :] >= 0)
    s = jnp.where(valid[None, :, None, None], s, NEG_INF)
    sink = sinks.astype(jnp.float32)[None, None, :, :, None, None]
    m = jnp.maximum(jnp.max(s, axis=-1, keepdims=True), sink)
    pexp = jnp.exp(s - m)
    denom = jnp.sum(pexp, axis=-1, keepdims=True) + jnp.exp(sink - m)
    return jnp.einsum('bnhgqk,bnkhd->bnqhgd', pexp / denom, v.astype(jnp.float32))


def _hgrn2(q, f_logit, i_in, lb, s0):
    B, T, _ = q.shape
    C = math.gcd(HG_CHUNK, T)
    nc = T // C
    lbf = lb.astype(jnp.float32)
    log_f = jnp.logaddexp(jnp.log(lbf), jnp.log1p(-lbf) + jax.nn.log_sigmoid(f_logit.astype(jnp.float32)))
    k = -jnp.expm1(log_f)

    def heads(a, d):
        return a.astype(jnp.float32).reshape(B, nc, C, HG_HEADS, d).transpose(1, 0, 2, 3, 4)

    qs, gs, ks, vs = heads(q, HG_DK), heads(log_f, HG_DK), heads(k, HG_DK), heads(i_in, HG_DV)
    causal = jnp.tril(jnp.ones((C, C), dtype=bool))[None, :, :, None, None]

    def step(S, blk):
        qc, gc, kc, vc = blk
        G = jnp.cumsum(gc, axis=1)
        diff = G[:, :, None] - G[:, None, :]
        decay = jnp.exp(jnp.where(causal, diff, NEG_INF))
        A = jnp.einsum('bthd,bshd,btshd->bhts', qc, kc, decay)
        o = jnp.einsum('bhts,bshv->bthv', A, vc) + jnp.einsum('bthd,bhdv->bthv', qc * jnp.exp(G), S)
        G_last = G[:, -1]
        S_new = jnp.exp(G_last)[..., None] * S + jnp.einsum(
            'bshd,bshv->bhdv', kc * jnp.exp(G_last[:, None] - G), vc)
        return S_new, o

    S_fin, o = lax.scan(step, s0.astype(jnp.float32), (qs, gs, ks, vs))
    o = o.transpose(1, 0, 2, 3, 4).reshape(B, T, HG_HEADS, HG_DV)
    return o, S_fin


def _mixer_layer(x, p, pos, k_buf, v_buf, s0, w_in, sinks, attn_g, lb, hg_g, w_out,
                 ln_g, ln_b, w_pp, w_pg):
    B, T, _ = x.shape
    z = jnp.einsum('btd,dc->btc', x, w_in)
    q, k, v, g_attn, hq, hf, hi, g_hg = jnp.split(z, _split_points(), axis=-1)
    q = _rope(q.reshape(B, T, ATTN_HEADS, HEAD_DIM), pos).reshape(B, T, KV_HEADS, Q_PER_KV, HEAD_DIM)
    k = _rope(k.reshape(B, T, KV_HEADS, HEAD_DIM), pos)
    v = v.reshape(B, T, KV_HEADS, HEAD_DIM).astype(jnp.float32)
    sk = sinks.reshape(KV_HEADS, Q_PER_KV)
    cache_w = min(WINDOW, PAST_LEN)
    if k_buf is None:
        nb = T // WINDOW
        qb = q.reshape(B, nb, WINDOW, KV_HEADS, Q_PER_KV, HEAD_DIM)
        kb = k.reshape(B, nb, WINDOW, KV_HEADS, HEAD_DIM)
        vb = v.reshape(B, nb, WINDOW, KV_HEADS, HEAD_DIM)
        k2 = jnp.concatenate([jnp.concatenate([jnp.zeros_like(kb[:, :1]), kb[:, :-1]], axis=1), kb], axis=2)
        v2 = jnp.concatenate([jnp.concatenate([jnp.zeros_like(vb[:, :1]), vb[:, :-1]], axis=1), vb], axis=2)
        qpos = pos.reshape(nb, WINDOW)
        kpos = jnp.concatenate([qpos - WINDOW, qpos], axis=1)
        attn = _sink_window_attend(qb, k2, v2, qpos, kpos, sk).reshape(B, T, ATTN_WIDTH)
        k_keep = k[:, T - cache_w:]
        v_keep = v[:, T - cache_w:]
    else:
        w = k_buf.shape[1]
        k_all = jnp.concatenate([k_buf.astype(jnp.float32), k], axis=1)
        v_all = jnp.concatenate([v_buf.astype(jnp.float32), v], axis=1)
        kpos = jnp.concatenate([PAST_LEN - w + jnp.arange(w, dtype=jnp.int32), pos])
        attn = _sink_window_attend(q[:, None], k_all[:, None], v_all[:, None], pos[None], kpos[None], sk)
        attn = attn.reshape(B, T, ATTN_WIDTH)
        k_keep = k_all[:, -w:]
        v_keep = v_all[:, -w:]
    attn = _rmsnorm(attn, attn_g) * jax.nn.silu(g_attn.astype(jnp.float32))
    o_hg, s_fin = _hgrn2(hq, hf, hi, lb, s0)
    o_hg = _rmsnorm(o_hg, hg_g.reshape(HG_HEADS, HG_DV)).reshape(B, T, HG_VW)
    o_hg = o_hg * jax.nn.silu(g_hg.astype(jnp.float32))
    mix = jnp.einsum('btc,cd->btd', jnp.concatenate([attn, o_hg], axis=-1), w_out.astype(jnp.float32))
    h = _layernorm(DN_ALPHA * x.astype(jnp.float32) + mix, ln_g, ln_b)
    gate = jax.nn.sigmoid(jnp.einsum('btd,de->bte', h, w_pg.astype(jnp.float32)))
    y = h + gate * jnp.einsum('btp,pd->btd', p.astype(jnp.float32), w_pp.astype(jnp.float32))
    return y, k_keep, v_keep, s_fin


def setup_inputs(seed: int = 0) -> dict:
    key = jax.random.key(seed)
    ks = jax.random.split(key, 20)
    cache_w = min(WINDOW, PAST_LEN)
    f32 = jnp.float32
    col_scale = jnp.concatenate([
        jnp.ones((ATTN_WIDTH + KV_WIDTH,), f32),
        jnp.full((KV_WIDTH,), DN_BETA, f32),
        jnp.ones((ATTN_WIDTH + 2 * HG_KW,), f32),
        jnp.full((HG_VW,), DN_BETA, f32),
        jnp.ones((HG_VW,), f32)])
    w_in = jax.random.normal(ks[7], (DEPTH, D_MODEL, IN_COLS), f32) * D_MODEL ** -0.5 * col_scale
    return {
        'x_prompt': jax.random.normal(ks[0], (BATCH, SEQ, D_MODEL), f32),
        'x_sample': jax.random.normal(ks[1], (DEC_BATCH, DEC_SEQ, D_MODEL), f32),
        'cache_k_win': jax.random.normal(ks[2], (DEPTH, DEC_BATCH, cache_w, KV_HEADS, HEAD_DIM), f32),
        'cache_v_win': jax.random.normal(ks[3], (DEPTH, DEC_BATCH, cache_w, KV_HEADS, HEAD_DIM), f32),
        'state_hgrn': 0.3 * jax.random.normal(ks[4], (DEPTH, DEC_BATCH, HG_HEADS, HG_DK, HG_DV), f32),
        'p_prompt': jax.random.normal(ks[5], (DEPTH, BATCH, SEQ, PLE_DIM), f32),
        'p_sample': jax.random.normal(ks[6], (DEPTH, DEC_BATCH, DEC_SEQ, PLE_DIM), f32),
        'w_in': w_in,
        'attn_sinks': 0.5 * jax.random.normal(ks[8], (DEPTH, ATTN_HEADS), f32),
        'attn_norm_g': 1.0 + 0.02 * jax.random.normal(ks[9], (DEPTH, ATTN_WIDTH), f32),
        'hg_lb_logits': 0.5 * jax.random.normal(ks[10], (DEPTH, HG_KW), f32),
        'hg_norm_g': 1.0 + 0.02 * jax.random.normal(ks[11], (DEPTH, HG_VW), f32),
        'w_out': jax.random.normal(ks[12], (DEPTH, MIX_WIDTH, D_MODEL), f32) * MIX_WIDTH ** -0.5 * DN_BETA,
        'ln_g': 1.0 + 0.02 * jax.random.normal(ks[13], (DEPTH, D_MODEL), f32),
        'ln_b': 0.02 * jax.random.normal(ks[14], (DEPTH, D_MODEL), f32),
        'w_ple_proj': jax.random.normal(ks[15], (DEPTH, PLE_DIM, D_MODEL), f32) * PLE_DIM ** -0.5,
        'w_ple_gate': jax.random.normal(ks[16], (DEPTH, D_MODEL, D_MODEL), f32) * D_MODEL ** -0.5,
    }


def reference(x_prompt, x_sample, cache_k_win, cache_v_win, state_hgrn, p_prompt, p_sample,
              w_in, attn_sinks, attn_norm_g, hg_lb_logits, hg_norm_g, w_out, ln_g, ln_b,
              w_ple_proj, w_ple_gate):
    cs = jnp.cumsum(jax.nn.softmax(hg_lb_logits.astype(jnp.float32), axis=0), axis=0)
    lbs = cs - cs[:1]
    pos_p = jnp.arange(x_prompt.shape[1], dtype=jnp.int32)
    pos_s = PAST_LEN + jnp.arange(x_sample.shape[1], dtype=jnp.int32)
    s0_p = jnp.zeros((x_prompt.shape[0], HG_HEADS, HG_DK, HG_DV), jnp.float32)
    yp, ys = x_prompt, x_sample
    kp_l, vp_l, sp_l, ks_l, vs_l, ss_l = [], [], [], [], [], []
    for i in range(DEPTH):
        lw = (w_in[i], attn_sinks[i], attn_norm_g[i], lbs[i], hg_norm_g[i], w_out[i],
              ln_g[i], ln_b[i], w_ple_proj[i], w_ple_gate[i])
        yp, kp, vp, sp = _mixer_layer(yp, p_prompt[i], pos_p, None, None, s0_p, *lw)
        ys, kk, vv, ss = _mixer_layer(ys, p_sample[i], pos_s, cache_k_win[i], cache_v_win[i],
                                      state_hgrn[i], *lw)
        kp_l.append(kp); vp_l.append(vp); sp_l.append(sp)
        ks_l.append(kk); vs_l.append(vv); ss_l.append(ss)
    new_k_win_prompt = jnp.stack(kp_l)
    new_v_win_prompt = jnp.stack(vp_l)
    new_state_hgrn_prompt = jnp.stack(sp_l)
    new_k_win_sample = jnp.stack(ks_l)
    new_v_win_sample = jnp.stack(vs_l)
    new_state_hgrn_sample = jnp.stack(ss_l)
    return (yp, ys, new_k_win_prompt, new_v_win_prompt, new_state_hgrn_prompt,
            new_k_win_sample, new_v_win_sample, new_state_hgrn_sample)
```

```cpp
#include <hip/hip_runtime.h>
#include <hip/hip_cooperative_groups.h>
#include <cstdio>
#include <cstdint>
namespace cg = cooperative_groups;
#ifndef DUP_PRO
#define DUP_PRO 1
#endif
#ifndef DUP_GIN
#define DUP_GIN 1
#endif
#ifndef DUP_MIX
#define DUP_MIX 1
#endif
#ifndef DUP_GOUT
#define DUP_GOUT 1
#endif
#ifndef DUP_GGATE
#define DUP_GGATE 1
#endif
#ifndef DUP_HP
#define DUP_HP 1
#endif
#ifndef DUP_PA
#define DUP_PA 1
#endif
#ifndef DUP_PB
#define DUP_PB 1
#endif
#ifndef DUP_PC
#define DUP_PC 1
#endif
#ifndef DUP_STG
#define DUP_STG 0
#endif
#ifndef DUP_ATTN
#define DUP_ATTN 1
#endif
#ifndef DUP_HS
#define DUP_HS 1
#endif
#ifndef DUP_SCAN
#define DUP_SCAN 1
#endif
#ifndef DUP_SYNC
#define DUP_SYNC 1
#endif

#define LAS __attribute__((address_space(3)))
typedef unsigned short bf16_t;
typedef short bf16x8 __attribute__((ext_vector_type(8)));
typedef float f32x4 __attribute__((ext_vector_type(4)));
typedef float f32x2 __attribute__((ext_vector_type(2)));
typedef unsigned u32x4 __attribute__((ext_vector_type(4)));
typedef unsigned u32x2 __attribute__((ext_vector_type(2)));

constexpr int RP = 16384;
constexpr int RS = 1024;
constexpr int R = RP + RS;
constexpr int DM = 1024;
constexpr int INC = 3328;
constexpr int NLAYER = 4;
constexpr float DN_ALPHA = 1.681792830507429f;
constexpr float NORM_EPS = 1e-5f;
constexpr int ZC_Q = 0, ZC_K = 512, ZC_V = 640, ZC_GA = 768, ZC_HQ = 1280, ZC_HF = 1792, ZC_HI = 2304, ZC_GH = 2816;
constexpr size_t O_Y = 0, O_KP = 17825792, O_VP = 18350080, O_SP = 18874368, O_KS = 20971520, O_VS = 29360128, O_SS = 37748736;
constexpr size_t WS_WIN = 0;
constexpr size_t WS_WOUT = WS_WIN + (size_t)4 * 3328 * 1024 * 2;
constexpr size_t WS_WPG = WS_WOUT + (size_t)4 * 1024 * 1024 * 2;
constexpr size_t WS_WPP = WS_WPG + (size_t)4 * 1024 * 1024 * 2;
constexpr size_t WS_C1 = WS_WPP + (size_t)4 * 1024 * 256 * 2;
constexpr size_t WS_C2 = WS_C1 + 16384;
constexpr size_t WS_LB = WS_C2 + 16384;
constexpr size_t WS_COS = WS_LB + 8192;
constexpr size_t WS_SIN = WS_COS + 263168;
constexpr size_t WS_XB = WS_SIN + 263168;
constexpr size_t WS_Z = WS_XB + (size_t)R * 1024 * 2;
constexpr size_t WS_MIX = WS_Z + (size_t)R * 3328 * 2;
constexpr size_t WS_PRE = WS_MIX + (size_t)R * 1024 * 2;
constexpr size_t WS_PREB = WS_PRE + (size_t)R * 1024 * 4;
constexpr size_t WS_STAT = WS_PREB + (size_t)R * 1024 * 2;
constexpr size_t WS_PB = WS_STAT + (size_t)R * 16 * 8;
constexpr size_t WS_PLE = WS_PB + (size_t)4 * R * 256 * 2;
constexpr size_t WS_BAR = WS_PLE + (size_t)R * 1024 * 2;
constexpr size_t WS_CP = WS_BAR + 16384;
constexpr size_t WS_END = WS_CP + 524288;
constexpr size_t WS_U = WS_PRE;
constexpr size_t WS_ST = WS_PREB;
constexpr size_t WS_DV = WS_PRE + 67108864;
static_assert(WS_DV + 1048576 <= WS_PREB, "DV fits in the PRE tail");
static_assert(WS_END <= (size_t)536870912, "workspace");
constexpr int LDS_BYTES = 135168;

struct Params {
    const float* x_prompt; const float* x_sample; const float* cache_k; const float* cache_v; const float* state;
    const float* p_prompt; const float* p_sample; const float* w_in; const float* sinks; const float* attn_g;
    const float* lb_logits; const float* hg_g; const float* w_out; const float* ln_g; const float* ln_b;
    const float* w_pp; const float* w_pg;
    float* out; unsigned char* ws;
};

__device__ __forceinline__ unsigned pk2(float lo, float hi) { unsigned r; asm volatile("v_cvt_pk_bf16_f32 %0, %1, %2" : "=v"(r) : "v"(lo), "v"(hi)); return r; }
__device__ __forceinline__ float bf2f(unsigned short b) { return __uint_as_float(((unsigned)b) << 16); }
__device__ __forceinline__ float bflo(unsigned w) { return __uint_as_float(w << 16); }
__device__ __forceinline__ float bfhi(unsigned w) { return __uint_as_float(w & 0xffff0000u); }
__device__ __forceinline__ float sigmoidf_(float x) { return __builtin_amdgcn_rcpf(1.0f + __expf(-x)); }

namespace pg8 {
constexpr int BM = 256, BK = 64, HALF = 128, HTB = HALF * BK * 2, STAGE_BYTES = 8 * HTB, NXCD = 8, WGM = 8;
__host__ __device__ __forceinline__ int lds_byte(int r, int c) { const int st = (r >> 4) * 2 + (c >> 5), rr = r & 15, cc = c & 31, ob = rr * 64 + cc * 2; return st * 1024 + (ob ^ (((ob >> 9) & 1) << 5)); }
__host__ __device__ __forceinline__ void stage_rc(int b, int& Rr, int& C) { const int st = b / 1024, sb = b % 1024, swz = sb ^ (((sb >> 9) & 1) << 5); Rr = (st >> 1) * 16 + swz / 64; C = (st & 1) * 32 + (swz % 64) / 2; }
__host__ __device__ __forceinline__ int perm32(int rho) { const int n = rho >> 4, i = rho & 15; return 8 * (i >> 2) + 4 * n + (i & 3); }
struct Unit { int pm, pn; };
struct Gemm { const bf16_t* A; const bf16_t* Bt; int M, N, K; };
struct StaticOrder {
    int nM, nN, nwg, G, c;
    __host__ __device__ void init(int M, int N, int G_, int c_) { nM = M / BM; nN = N / BM; nwg = nM * nN; G = G_; c = c_; }
    __host__ __device__ bool next(int i, Unit& u) const {
        const long L = (long)i * G + c; if (L >= nwg) return false;
        int wgid = (int)L; { const int q = nwg / NXCD, r = nwg % NXCD, xcd = wgid % NXCD, off = wgid / NXCD; wgid = (xcd < r ? xcd * (q + 1) : r * (q + 1) + (xcd - r) * q) + off; }
        const int nig = WGM * nN, gid = wgid / nig, fm = gid * WGM, gsz = (nM - fm) < WGM ? (nM - fm) : WGM;
        u.pm = fm + ((wgid % nig) % gsz); u.pn = (wgid % nig) / gsz; return true;
    }
};

template <class Epi, class Sched>
__device__ __forceinline__ void gemm_phase(LAS unsigned char* lds, const Gemm g, const Sched& S, const Epi& E) {
    int tid = threadIdx.x; asm volatile("" : "+v"(tid));
    const int wid = __builtin_amdgcn_readfirstlane(tid >> 6), lane = tid & 63, wr = wid >> 2, wc = wid & 3, fr = lane & 15, fq = lane >> 4;
    const int K = g.K, nt = K / BK;
    unsigned voffA[2], voffB[2];
#pragma unroll
    for (int i = 0; i < 2; ++i) { int Rr, C; stage_rc(tid * 16 + i * 8192, Rr, C); const int Rb = Epi::PERM ? ((Rr & ~31) + perm32(Rr & 31)) : Rr;
        voffA[i] = (unsigned)(Rr * K + C) * 2u; voffB[i] = (unsigned)(Rb * K + C) * 2u; }
    const size_t kstep = (size_t)(BK * 2);
    const size_t hstep = (size_t)HALF * K * 2;
    const size_t tstep = 2 * hstep;
    const unsigned ldsw = (unsigned)wid * 1024u;
    const int aoff = lds_byte(wr * 64 + fr, fq * 8), boff = lds_byte(wc * 32 + fr, fq * 8);
#define PG8_SA(b, h) (((b) * 2 + (h)) * HTB)
#define PG8_SB(b, h) ((4 + (b) * 2 + (h)) * HTB)
#define PG8_STAGE(bufoff, gbase, voff) do { _Pragma("unroll") for (int _i = 0; _i < 2; ++_i) \
        __builtin_amdgcn_global_load_lds((const unsigned*)((const char*)(gbase) + (voff)[_i]), (LAS unsigned*)(lds + (bufoff) + ldsw + _i * 8192), 16, 0, 0); } while (0)
#define PG8_LDA(dst, b, h) do { _Pragma("unroll") for (int m = 0; m < 4; ++m) _Pragma("unroll") for (int k = 0; k < 2; ++k) dst[m][k] = *(const LAS bf16x8*)(lds + PG8_SA(b, h) + aoff + m * 2048 + k * 1024); } while (0)
#define PG8_LDB(dst, b, h) do { _Pragma("unroll") for (int n = 0; n < 2; ++n) _Pragma("unroll") for (int k = 0; k < 2; ++k) dst[n][k] = *(const LAS bf16x8*)(lds + PG8_SB(b, h) + boff + n * 2048 + k * 1024); } while (0)
#define PG8_MMA(ai, bj, At, Bt) do { __builtin_amdgcn_s_setprio(1); _Pragma("unroll") for (int m = 0; m < 4; ++m) _Pragma("unroll") for (int n = 0; n < 2; ++n) _Pragma("unroll") for (int k = 0; k < 2; ++k) \
        acc[ai][bj][m][n] = __builtin_amdgcn_mfma_f32_16x16x32_bf16(Bt[n][k], At[m][k], acc[ai][bj][m][n], 0, 0, 0); __builtin_amdgcn_s_setprio(0); } while (0)
#define PG8_WAIT_V(n) asm volatile("s_waitcnt vmcnt(" #n ")" ::: "memory")
#define PG8_WAIT_L(n) asm volatile("s_waitcnt lgkmcnt(" #n ")" ::: "memory")
#define PG8_BAR __builtin_amdgcn_s_barrier()
#define PG8_SCHED __builtin_amdgcn_sched_barrier(0)
    Unit cur, nxt; int ui = 0;
    if (!S.next(0, cur)) return;
    f32x4 acc[2][2][4][2];
#pragma unroll
    for (int a = 0; a < 2; ++a)
#pragma unroll
        for (int b = 0; b < 2; ++b)
#pragma unroll
            for (int m = 0; m < 4; ++m)
#pragma unroll
                for (int n = 0; n < 2; ++n) acc[a][b][m][n] = (f32x4){0.f, 0.f, 0.f, 0.f};
    bf16x8 At[4][2], B0[2][2], B1[2][2];
    const char* cA = (const char*)g.A + (size_t)cur.pm * tstep; const char* cB = (const char*)g.Bt + (size_t)cur.pn * tstep;
    PG8_STAGE(PG8_SB(0, 0), cB, voffB); PG8_STAGE(PG8_SB(0, 1), cB + hstep, voffB); PG8_STAGE(PG8_SA(0, 0), cA, voffA); PG8_STAGE(PG8_SA(0, 1), cA + hstep, voffA);
    if (wr == 1) PG8_BAR;
    PG8_WAIT_V(2); PG8_BAR;
    PG8_STAGE(PG8_SB(1, 0), cB + kstep, voffB); PG8_STAGE(PG8_SA(1, 0), cA + kstep, voffA); PG8_STAGE(PG8_SB(1, 1), cB + hstep + kstep, voffB);
    PG8_WAIT_V(6); PG8_BAR;
    for (;;) {
        const bool has_next = S.next(ui + 1, nxt);
        const char* nA = has_next ? (const char*)g.A + (size_t)nxt.pm * tstep : cA; const char* nB = has_next ? (const char*)g.Bt + (size_t)nxt.pn * tstep : cB;
#pragma unroll 1
        for (int t = 0; t < nt; t += 2) {
            const bool last = (t == nt - 2);
            const char* a1 = cA + (size_t)(t + 1) * kstep;
            const char* a2 = last ? nA : cA + (size_t)(t + 2) * kstep; const char* b2 = last ? nB : cB + (size_t)(t + 2) * kstep;
            const char* a3 = a2 + kstep; const char* b3 = b2 + kstep;
            PG8_LDB(B0, 0, 0); PG8_LDB(B1, 0, 1); PG8_SCHED; PG8_LDA(At, 0, 0); PG8_STAGE(PG8_SA(1, 1), a1 + hstep, voffA);
            PG8_WAIT_V(8); PG8_WAIT_L(0); PG8_BAR; PG8_MMA(0, 0, At, B0); PG8_MMA(0, 1, At, B1); PG8_BAR; PG8_SCHED;
            PG8_LDA(At, 0, 1); PG8_STAGE(PG8_SB(0, 0), b2, voffB); PG8_STAGE(PG8_SB(0, 1), b2 + hstep, voffB); PG8_STAGE(PG8_SA(0, 0), a2, voffA);
            PG8_WAIT_V(8); PG8_WAIT_L(0); PG8_BAR; PG8_MMA(1, 0, At, B0); PG8_MMA(1, 1, At, B1); PG8_BAR; PG8_SCHED;
            PG8_LDB(B0, 1, 0); PG8_LDB(B1, 1, 1); PG8_SCHED; PG8_LDA(At, 1, 0); PG8_STAGE(PG8_SA(0, 1), a2 + hstep, voffA);
            PG8_WAIT_V(8); PG8_WAIT_L(0); PG8_BAR; PG8_MMA(0, 0, At, B0); PG8_MMA(0, 1, At, B1); PG8_BAR; PG8_SCHED;
            PG8_LDA(At, 1, 1); PG8_STAGE(PG8_SB(1, 0), b3, voffB); PG8_STAGE(PG8_SB(1, 1), b3 + hstep, voffB); PG8_STAGE(PG8_SA(1, 0), a3, voffA);
            PG8_WAIT_V(8); PG8_WAIT_L(0); PG8_BAR; PG8_MMA(1, 0, At, B0); PG8_MMA(1, 1, At, B1); PG8_BAR; PG8_SCHED;
        }
        if (wr == 0) PG8_BAR;
        E(acc, cur, wr, wc, fr, fq);
        if (!has_next) break;
#pragma unroll
        for (int a = 0; a < 2; ++a)
#pragma unroll
            for (int b = 0; b < 2; ++b)
#pragma unroll
                for (int m = 0; m < 4; ++m)
#pragma unroll
                    for (int n = 0; n < 2; ++n) acc[a][b][m][n] = (f32x4){0.f, 0.f, 0.f, 0.f};
        cur = nxt; cA = nA; cB = nB; ++ui;
        if (wr == 1) PG8_BAR;
    }
    PG8_WAIT_V(0);
    PG8_BAR;
#undef PG8_SA
#undef PG8_SB
#undef PG8_STAGE
#undef PG8_LDA
#undef PG8_LDB
#undef PG8_MMA
#undef PG8_WAIT_V
#undef PG8_WAIT_L
#undef PG8_BAR
#undef PG8_SCHED
}
}

struct EpiIn {
    static constexpr bool PERM = true;
    bf16_t* Z; const float* cosT; const float* sinT; const float* lb;
    float* kout_p; float* vout_p; float* kout_s; float* vout_s;
    template <int MODE>
    __device__ __forceinline__ void run(const f32x4 (&acc)[2][2][4][2], const pg8::Unit& u, int wr, int wc, int fr, int fq) const {
        const int pn = u.pn;
        constexpr bool ROPE_ANY = (MODE == 0 || MODE == 1);
        const int i0 = (wc & 1) * 16 + 4 * fq;
        f32x4 lbv[2][2];
        if (MODE == 4) {
#pragma unroll
            for (int bj = 0; bj < 2; ++bj) { const float* lp = lb + (pn - 7) * 256 + bj * 128 + wc * 32 + 8 * fq; lbv[bj][0] = *(const f32x4*)lp; lbv[bj][1] = *(const f32x4*)(lp + 4); }
        }
#pragma unroll
        for (int ai = 0; ai < 2; ++ai)
#pragma unroll
            for (int mp = 0; mp < 2; ++mp) {
                f32x4 csv[2], snv[2];
                if (ROPE_ANY) {
#pragma unroll
                    for (int k = 0; k < 2; ++k) {
                        const int row = u.pm * 256 + ai * 128 + wr * 64 + (2 * mp + k) * 16 + fr;
                        const int pidx = row < RP ? (row & 2047) : 2048 + ((row - RP) & 7);
                        csv[k] = *(const f32x4*)(cosT + pidx * 32 + i0); snv[k] = *(const f32x4*)(sinT + pidx * 32 + i0);
                    }
                }
#pragma unroll
                for (int k = 0; k < 2; ++k) {
                    const int m = 2 * mp + k;
                    const int row = u.pm * 256 + ai * 128 + wr * 64 + m * 16 + fr;
                    bf16_t* zrow = Z + (size_t)row * INC + pn * 256 + wc * 32 + 8 * fq;
                    float* kdst = nullptr; float* vdst = nullptr;
                    if (MODE == 1) {
                        const int kvh = wc >> 1;
                        if (row < RP) { const int t = row & 2047; if (t >= 1920) { const size_t o = ((size_t)((row >> 11) * 128 + (t - 1920)) * 2 + kvh) * 64; kdst = kout_p + o; vdst = vout_p + o; } }
                        else { const int rs = row - RP; const size_t o = ((size_t)((rs >> 3) * 128 + 120 + (rs & 7)) * 2 + kvh) * 64; kdst = kout_s + o; vdst = vout_s + o; }
                    }
#pragma unroll
                    for (int bj = 0; bj < 2; ++bj) {
                        f32x4 v0 = acc[ai][bj][m][0], v1 = acc[ai][bj][m][1];
                        const int co = bj * 128;
                        if (MODE == 0 || (MODE == 1 && bj == 0)) {
                            const f32x4 cs = csv[k], sn = snv[k];
                            f32x4 o0, o1;
                            o0.x = v0.x * cs.x - v0.y * sn.x; o0.y = v0.y * cs.x + v0.x * sn.x;
                            o0.z = v0.z * cs.y - v0.w * sn.y; o0.w = v0.w * cs.y + v0.z * sn.y;
                            o1.x = v1.x * cs.z - v1.y * sn.z; o1.y = v1.y * cs.z + v1.x * sn.z;
                            o1.z = v1.z * cs.w - v1.w * sn.w; o1.w = v1.w * cs.w + v1.z * sn.w;
                            if (MODE == 0) { o0 = o0 * 0.18033688011112042f; o1 = o1 * 0.18033688011112042f; }
                            else if (kdst) {
                                kdst[i0] = o0.x; kdst[i0 + 32] = o0.y; kdst[i0 + 1] = o0.z; kdst[i0 + 33] = o0.w;
                                kdst[i0 + 2] = o1.x; kdst[i0 + 34] = o1.y; kdst[i0 + 3] = o1.z; kdst[i0 + 35] = o1.w;
                            }
                            v0 = o0; v1 = o1;
                        } else if (MODE == 1) {
                            const int d0 = (wc & 1) * 32 + 8 * fq;
                            if (vdst) { *(f32x4*)(vdst + d0) = v0; *(f32x4*)(vdst + d0 + 4) = v1; }
                        } else if (MODE == 2) {
                            v0.x = v0.x * sigmoidf_(v0.x); v0.y = v0.y * sigmoidf_(v0.y); v0.z = v0.z * sigmoidf_(v0.z); v0.w = v0.w * sigmoidf_(v0.w);
                            v1.x = v1.x * sigmoidf_(v1.x); v1.y = v1.y * sigmoidf_(v1.y); v1.z = v1.z * sigmoidf_(v1.z); v1.w = v1.w * sigmoidf_(v1.w);
                        } else if (MODE == 4) {
                            const f32x4 l0 = lbv[bj][0], l1 = lbv[bj][1];
                            f32x4 o0, o1;
                            { const float sg = __builtin_amdgcn_rcpf(1.0f + __expf(-fmaxf(v0.x, -80.f))); o0.x = __logf(l0.x + (1.f - l0.x) * sg); }
                            { const float sg = __builtin_amdgcn_rcpf(1.0f + __expf(-fmaxf(v0.y, -80.f))); o0.y = __logf(l0.y + (1.f - l0.y) * sg); }
                            { const float sg = __builtin_amdgcn_rcpf(1.0f + __expf(-fmaxf(v0.z, -80.f))); o0.z = __logf(l0.z + (1.f - l0.z) * sg); }
                            { const float sg = __builtin_amdgcn_rcpf(1.0f + __expf(-fmaxf(v0.w, -80.f))); o0.w = __logf(l0.w + (1.f - l0.w) * sg); }
                            { const float sg = __builtin_amdgcn_rcpf(1.0f + __expf(-fmaxf(v1.x, -80.f))); o1.x = __logf(l1.x + (1.f - l1.x) * sg); }
                            { const float sg = __builtin_amdgcn_rcpf(1.0f + __expf(-fmaxf(v1.y, -80.f))); o1.y = __logf(l1.y + (1.f - l1.y) * sg); }
                            { const float sg = __builtin_amdgcn_rcpf(1.0f + __expf(-fmaxf(v1.z, -80.f))); o1.z = __logf(l1.z + (1.f - l1.z) * sg); }
                            { const float sg = __builtin_amdgcn_rcpf(1.0f + __expf(-fmaxf(v1.w, -80.f))); o1.w = __logf(l1.w + (1.f - l1.w) * sg); }
                            v0 = o0; v1 = o1;
                        }
                        u32x4 w; w.x = pk2(v0.x, v0.y); w.y = pk2(v0.z, v0.w); w.z = pk2(v1.x, v1.y); w.w = pk2(v1.z, v1.w);
                        *(u32x4*)(zrow + co) = w;
                    }
                }
                asm volatile("" ::: "memory");
            }
    }
    __device__ __forceinline__ void operator()(const f32x4 (&acc)[2][2][4][2], const pg8::Unit& u, int wr, int wc, int fr, int fq) const {
        const int pn = u.pn;
        if (pn < 2) run<0>(acc, u, wr, wc, fr, fq);
        else if (pn == 2) run<1>(acc, u, wr, wc, fr, fq);
        else if (pn == 3 || pn == 4 || pn >= 11) run<2>(acc, u, wr, wc, fr, fq);
        else if (pn == 7 || pn == 8) run<4>(acc, u, wr, wc, fr, fq);
        else run<3>(acc, u, wr, wc, fr, fq);
    }
};

struct EpiOut {
    static constexpr bool PERM = true;
    const float* xf_p; const float* xf_s;
    const bf16_t* xb;
    bf16_t* preb; f32x2* stat; int pm0;
    __device__ __forceinline__ void operator()(const f32x4 (&acc)[2][2][4][2], const pg8::Unit& u, int wr, int wc, int fr, int fq) const {
        const int c0 = u.pn * 256 + wc * 32 + 8 * fq;
#pragma unroll
        for (int ai = 0; ai < 2; ++ai) {
            u32x4 xw[4][2];
            if (!xf_p) {
#pragma unroll
                for (int m = 0; m < 4; ++m)
#pragma unroll
                    for (int bj = 0; bj < 2; ++bj)
                        xw[m][bj] = *(const u32x4*)(xb + (size_t)((u.pm + pm0) * 256 + ai * 128 + wr * 64 + m * 16 + fr) * DM + c0 + bj * 128);
            }
#pragma unroll
            for (int m = 0; m < 4; ++m) {
                const int row = (u.pm + pm0) * 256 + ai * 128 + wr * 64 + m * 16 + fr;
                bf16_t* pb = preb + (size_t)row * DM + c0;
                float s1 = 0.f, s2 = 0.f;
#pragma unroll
                for (int bj = 0; bj < 2; ++bj) {
                    const int co = bj * 128;
                    f32x4 x0, x1;
                    if (xf_p) { const float* xp = (row < RP ? xf_p + (size_t)row * DM : xf_s + (size_t)(row - RP) * DM) + c0 + co; x0 = *(const f32x4*)xp; x1 = *(const f32x4*)(xp + 4); }
                    else { const u32x4 w4 = xw[m][bj]; x0 = (f32x4){bflo(w4.x), bfhi(w4.x), bflo(w4.y), bfhi(w4.y)}; x1 = (f32x4){bflo(w4.z), bfhi(w4.z), bflo(w4.w), bfhi(w4.w)}; }
                    const f32x4 v0 = x0 * DN_ALPHA + acc[ai][bj][m][0], v1 = x1 * DN_ALPHA + acc[ai][bj][m][1];
                    s1 += ((v0.x + v0.y) + (v0.z + v0.w)) + ((v1.x + v1.y) + (v1.z + v1.w));
                    s2 += ((v0.x * v0.x + v0.y * v0.y) + (v0.z * v0.z + v0.w * v0.w)) + ((v1.x * v1.x + v1.y * v1.y) + (v1.z * v1.z + v1.w * v1.w));
                    u32x4 w; w.x = pk2(v0.x, v0.y); w.y = pk2(v0.z, v0.w); w.z = pk2(v1.x, v1.y); w.w = pk2(v1.z, v1.w);
                    *(u32x4*)(pb + co) = w;
                }
                s1 += __shfl_xor(s1, 16); s1 += __shfl_xor(s1, 32);
                s2 += __shfl_xor(s2, 16); s2 += __shfl_xor(s2, 32);
                if (fq == 0) stat[(size_t)row * 16 + u.pn * 4 + wc] = (f32x2){s1, s2};
            }
        }
    }
};

struct EpiPle {
    static constexpr bool PERM = true;
    bf16_t* ple;
    __device__ __forceinline__ void operator()(const f32x4 (&acc)[2][2][4][2], const pg8::Unit& u, int wr, int wc, int fr, int fq) const {
#pragma unroll
        for (int ai = 0; ai < 2; ++ai)
#pragma unroll
            for (int m = 0; m < 4; ++m) {
                const int row = u.pm * 256 + ai * 128 + wr * 64 + m * 16 + fr;
                bf16_t* pr = ple + (size_t)row * DM + u.pn * 256 + wc * 32 + 8 * fq;
#pragma unroll
                for (int bj = 0; bj < 2; ++bj) {
                    const f32x4 v0 = acc[ai][bj][m][0], v1 = acc[ai][bj][m][1];
                    u32x4 w; w.x = pk2(v0.x, v0.y); w.y = pk2(v0.z, v0.w); w.z = pk2(v1.x, v1.y); w.w = pk2(v1.z, v1.w);
                    *(u32x4*)(pr + bj * 128) = w;
                }
            }
    }
};

struct EpiGate {
    static constexpr bool PERM = true;
    const bf16_t* preb; const f32x2* stat; const bf16_t* ple; const float* c1; const float* c2; const float* lng; const float* lnb;
    float* yout; bf16_t* xb; LAS f32x2* srow; int pm0;
    __device__ __forceinline__ f32x4 four(const f32x4 a, const float pv0, const float pv1, const float pv2, const float pv3, const float pl0, const float pl1, const float pl2, const float pl3,
                                          const float mean, const float rs, const f32x4 c1v, const f32x4 c2v, const f32x4 gv, const f32x4 bv) const {
        f32x4 y;
        y.x = (pv0 - mean) * rs * gv.x + bv.x + sigmoidf_(rs * (a.x - mean * c1v.x) + c2v.x) * pl0;
        y.y = (pv1 - mean) * rs * gv.y + bv.y + sigmoidf_(rs * (a.y - mean * c1v.y) + c2v.y) * pl1;
        y.z = (pv2 - mean) * rs * gv.z + bv.z + sigmoidf_(rs * (a.z - mean * c1v.z) + c2v.z) * pl2;
        y.w = (pv3 - mean) * rs * gv.w + bv.w + sigmoidf_(rs * (a.w - mean * c1v.w) + c2v.w) * pl3;
        return y;
    }
    __device__ __forceinline__ void operator()(const f32x4 (&acc)[2][2][4][2], const pg8::Unit& u, int wr, int wc, int fr, int fq) const {
        {
            const int tid = threadIdx.x;
            if (tid < 256) {
                const f32x4* sp = (const f32x4*)(stat + (size_t)((u.pm + pm0) * 256 + tid) * 16);
                float s1 = 0.f, s2 = 0.f;
#pragma unroll
                for (int i = 0; i < 8; ++i) { const f32x4 t = sp[i]; s1 += t.x + t.z; s2 += t.y + t.w; }
                const float mean = s1 * (1.0f / DM);
                const float var = fmaxf(s2 * (1.0f / DM) - mean * mean, 0.f);
                srow[tid] = (f32x2){mean, rsqrtf(var + NORM_EPS)};
            }
            asm volatile("s_waitcnt lgkmcnt(0)" ::: "memory");
            __builtin_amdgcn_s_barrier();
            asm volatile("" ::: "memory");
        }
        float mu[2][4], rstd[2][4];
#pragma unroll
        for (int ai = 0; ai < 2; ++ai)
#pragma unroll
            for (int m = 0; m < 4; ++m) { const f32x2 t = srow[ai * 128 + wr * 64 + m * 16 + fr]; mu[ai][m] = t.x; rstd[ai][m] = t.y; }
#pragma unroll
        for (int bj = 0; bj < 2; ++bj) {
            const int c0 = u.pn * 256 + wc * 32 + 8 * fq + bj * 128;
            const f32x4 c1a = *(const f32x4*)(c1 + c0), c1b = *(const f32x4*)(c1 + c0 + 4), c2a = *(const f32x4*)(c2 + c0), c2b = *(const f32x4*)(c2 + c0 + 4);
            const f32x4 ga = *(const f32x4*)(lng + c0), gb = *(const f32x4*)(lng + c0 + 4), ba = *(const f32x4*)(lnb + c0), bb = *(const f32x4*)(lnb + c0 + 4);
#pragma unroll
            for (int am = 0; am < 4; ++am) {
                const int ai = am >> 1;
                u32x4 pvw[2], pw[2];
#pragma unroll
                for (int k = 0; k < 2; ++k) {
                    const int m = (am & 1) * 2 + k;
                    const size_t off = (size_t)((u.pm + pm0) * 256 + ai * 128 + wr * 64 + m * 16 + fr) * DM + c0;
                    pvw[k] = *(const u32x4*)(preb + off); pw[k] = *(const u32x4*)(ple + off);
                }
#pragma unroll
                for (int k = 0; k < 2; ++k) {
                    const int m = (am & 1) * 2 + k;
                    const size_t off = (size_t)((u.pm + pm0) * 256 + ai * 128 + wr * 64 + m * 16 + fr) * DM + c0;
                    const float mean = mu[ai][m], rs = rstd[ai][m];
                    const f32x4 y0 = four(acc[ai][bj][m][0], bflo(pvw[k].x), bfhi(pvw[k].x), bflo(pvw[k].y), bfhi(pvw[k].y), bflo(pw[k].x), bfhi(pw[k].x), bflo(pw[k].y), bfhi(pw[k].y), mean, rs, c1a, c2a, ga, ba);
                    const f32x4 y1 = four(acc[ai][bj][m][1], bflo(pvw[k].z), bfhi(pvw[k].z), bflo(pvw[k].w), bfhi(pvw[k].w), bflo(pw[k].z), bfhi(pw[k].z), bflo(pw[k].w), bfhi(pw[k].w), mean, rs, c1b, c2b, gb, bb);
                    if (yout) { *(f32x4*)(yout + off) = y0; *(f32x4*)(yout + off + 4) = y1; }
                    if (xb) { u32x4 w; w.x = pk2(y0.x, y0.y); w.y = pk2(y0.z, y0.w); w.z = pk2(y1.x, y1.y); w.w = pk2(y1.z, y1.w); *(u32x4*)(xb + off) = w; }
                }
                asm volatile("" ::: "memory");
            }
        }
    }
};

struct TItem { const float* W; bf16_t* WT; const float* gk; const float* bk; float* cp; int K, N, item, perm; };
__device__ __forceinline__ TItem p0_decode(const Params& P, int it) {
    constexpr int I_IN = 16 * 104, I_SQ = 16 * 32, I_PP = 4 * 32, I_L = I_IN + 2 * I_SQ + I_PP;
    const int l = it / I_L; int r = it % I_L;
    TItem t; t.gk = nullptr; t.bk = nullptr; t.cp = nullptr; t.perm = 0;
    if (r < I_IN) { t.W = P.w_in + (size_t)l * 1024 * INC; t.K = 1024; t.N = INC; t.WT = (bf16_t*)(P.ws + WS_WIN) + (size_t)l * INC * 1024; t.perm = 1; t.item = r; return t; }
    r -= I_IN;
    if (r < I_SQ) { t.W = P.w_out + (size_t)l * 1024 * 1024; t.K = 1024; t.N = 1024; t.WT = (bf16_t*)(P.ws + WS_WOUT) + (size_t)l * 1024 * 1024; t.item = r; return t; }
    r -= I_SQ;
    if (r < I_SQ) { t.W = P.w_pg + (size_t)l * 1024 * 1024; t.K = 1024; t.N = 1024; t.WT = (bf16_t*)(P.ws + WS_WPG) + (size_t)l * 1024 * 1024;
                    t.gk = P.ln_g + l * 1024; t.bk = P.ln_b + l * 1024; t.cp = (float*)(P.ws + WS_CP) + (size_t)l * 32768; t.item = r; return t; }
    r -= I_SQ;
    t.W = P.w_pp + (size_t)l * 256 * 1024; t.K = 256; t.N = 1024; t.WT = (bf16_t*)(P.ws + WS_WPP) + (size_t)l * 1024 * 256; t.item = r; return t;
}
__device__ __forceinline__ void p0_item_load(const TItem& t, f32x4 (&v)[8], int lane) {
    const int nblk = t.N / 32, kb = t.item / nblk, nb = t.item % nblk, k0 = 64 * kb, n0 = 32 * nb;
    const int r8 = lane >> 3, c4 = lane & 7;
#pragma unroll
    for (int i = 0; i < 8; ++i) v[i] = *(const f32x4*)(t.W + (size_t)(k0 + r8 + 8 * i) * t.N + n0 + c4 * 4);
}
__device__ __forceinline__ void p0_item_finish(const TItem& t, const f32x4 (&v)[8], LAS float* scr, int lane) {
    const int K = t.K, N = t.N;
    const int nblk = N / 32, kb = t.item / nblk, nb = t.item % nblk, k0 = 64 * kb, n0 = 32 * nb;
    const int r8 = lane >> 3, c4 = lane & 7;
#pragma unroll
    for (int i = 0; i < 8; ++i) { LAS float* p = scr + (r8 + 8 * i) * 33 + c4 * 4; p[0] = v[i].x; p[1] = v[i].y; p[2] = v[i].z; p[3] = v[i].w; }
    asm volatile("s_waitcnt lgkmcnt(0)" ::: "memory");
    if (t.cp) {
        const int n = lane & 31, half = lane >> 5;
        float s1 = 0.f, s2 = 0.f;
#pragma unroll 8
        for (int kk = half * 32; kk < half * 32 + 32; ++kk) { const float w = scr[kk * 33 + n]; s1 += t.gk[k0 + kk] * w; s2 += t.bk[k0 + kk] * w; }
        s1 += __shfl_xor(s1, 32); s2 += __shfl_xor(s2, 32);
        if (lane < 32) { t.cp[(size_t)kb * 2048 + n0 + n] = s1; t.cp[(size_t)kb * 2048 + 1024 + n0 + n] = s2; }
    }
    const int c = lane & 7;
    f32x4 g0 = (f32x4){1.f, 1.f, 1.f, 1.f}, g1 = g0;
    if (t.gk) { g0 = *(const f32x4*)(t.gk + k0 + 8 * c); g1 = *(const f32x4*)(t.gk + k0 + 8 * c + 4); }
#pragma unroll
    for (int j = 0; j < 4; ++j) {
        const int n = (lane >> 3) + 8 * j; const LAS float* sp = scr + (8 * c) * 33 + n;
        u32x4 o; o.x = pk2(sp[0 * 33] * g0.x, sp[1 * 33] * g0.y); o.y = pk2(sp[2 * 33] * g0.z, sp[3 * 33] * g0.w); o.z = pk2(sp[4 * 33] * g1.x, sp[5 * 33] * g1.y); o.w = pk2(sp[6 * 33] * g1.z, sp[7 * 33] * g1.w);
        int nd = n0 + n;
        if (t.perm && nd < 640) { const int dd = nd & 63; nd = (nd & ~63) + (dd < 32 ? 2 * dd : 2 * (dd - 32) + 1); }
        *(u32x4*)(t.WT + (size_t)nd * K + k0 + 8 * c) = o;
    }
    asm volatile("s_waitcnt lgkmcnt(0)" ::: "memory");
}

__device__ __forceinline__ void prologue(const Params& P, LAS unsigned char* lds) {
    int tid = threadIdx.x; asm volatile("" : "+v"(tid));
    const int wave = tid >> 6, lane = tid & 63;
    const int G = gridDim.x;
    const int gw = blockIdx.x * 8 + wave, NGW = G * 8;
    LAS float* scr = (LAS float*)(lds + wave * 8448);
    {
        constexpr int I_L = 16 * 104 + 2 * 16 * 32 + 4 * 32, TOTAL = NLAYER * I_L;
        if (gw < TOTAL) {
            TItem cur = p0_decode(P, gw); f32x4 v[8];
            p0_item_load(cur, v, lane);
#pragma unroll 1
            for (int it = gw; it < TOTAL; it += NGW) {
                const bool has = it + NGW < TOTAL;
                TItem nxt = cur; f32x4 w[8];
                if (has) { nxt = p0_decode(P, it + NGW); p0_item_load(nxt, w, lane); }
                p0_item_finish(cur, v, scr, lane);
                if (has) { cur = nxt;
#pragma unroll
                    for (int i = 0; i < 8; ++i) v[i] = w[i]; }
            }
        }
    }
    const size_t gt = (size_t)blockIdx.x * 512 + tid, GT = (size_t)G * 512;
    for (size_t ch0 = gt; ch0 < (size_t)R * 128; ch0 += 4 * GT) {
        f32x4 a[4], b[4];
#pragma unroll
        for (int k = 0; k < 4; ++k) {
            const size_t ch = ch0 + (size_t)k * GT;
            if (ch < (size_t)R * 128) {
                const size_t row = ch >> 7; const int c8 = (int)(ch & 127) * 8;
                const float* src = (row < RP ? P.x_prompt + row * DM : P.x_sample + (row - RP) * DM) + c8;
                a[k] = *(const f32x4*)src; b[k] = *(const f32x4*)(src + 4);
            }
        }
#pragma unroll
        for (int k = 0; k < 4; ++k) {
            const size_t ch = ch0 + (size_t)k * GT;
            if (ch < (size_t)R * 128) {
                const size_t row = ch >> 7; const int c8 = (int)(ch & 127) * 8;
                u32x4 o; o.x = pk2(a[k].x, a[k].y); o.y = pk2(a[k].z, a[k].w); o.z = pk2(b[k].x, b[k].y); o.w = pk2(b[k].z, b[k].w);
                *(u32x4*)((bf16_t*)(P.ws + WS_XB) + row * DM + c8) = o;
            }
        }
    }
    for (size_t ch0 = gt; ch0 < (size_t)NLAYER * R * 32; ch0 += 4 * GT) {
        f32x4 a[4], b[4];
#pragma unroll
        for (int k = 0; k < 4; ++k) {
            const size_t ch = ch0 + (size_t)k * GT;
            if (ch < (size_t)NLAYER * R * 32) {
                const size_t lr = ch >> 5; const int c8 = (int)(ch & 31) * 8;
                const size_t l = lr / R, row = lr % R;
                const float* src = (row < RP ? P.p_prompt + (l * RP + row) * 256 : P.p_sample + (l * RS + (row - RP)) * 256) + c8;
                a[k] = *(const f32x4*)src; b[k] = *(const f32x4*)(src + 4);
            }
        }
#pragma unroll
        for (int k = 0; k < 4; ++k) {
            const size_t ch = ch0 + (size_t)k * GT;
            if (ch < (size_t)NLAYER * R * 32) {
                const size_t lr = ch >> 5; const int c8 = (int)(ch & 31) * 8;
                u32x4 o; o.x = pk2(a[k].x, a[k].y); o.y = pk2(a[k].z, a[k].w); o.z = pk2(b[k].x, b[k].y); o.w = pk2(b[k].z, b[k].w);
                *(u32x4*)((bf16_t*)(P.ws + WS_PB) + lr * 256 + c8) = o;
            }
        }
    }
    for (size_t e = gt; e < (size_t)2056 * 32; e += GT) {
        const int pi = (int)(e >> 5), i = (int)(e & 31);
        const int pos = pi < 2048 ? pi : 8192 + (pi - 2048);
        const float inv = expf(-9.210340371976184f * (float)i * 2.0f / 64.0f);
        const float angf = (float)pos * inv;
        const double a = (double)angf;
        const double q = rint(a * 0.63661977236758134308);
        const double r = a - q * 1.57079632679489661923;
        const double r2 = r * r;
        const double sn = r * (1.0 + r2 * (-1.0 / 6 + r2 * (1.0 / 120 + r2 * (-1.0 / 5040 + r2 * (1.0 / 362880 + r2 * (-1.0 / 39916800 + r2 * (1.0 / 6227020800.0)))))));
        const double cs = 1.0 + r2 * (-0.5 + r2 * (1.0 / 24 + r2 * (-1.0 / 720 + r2 * (1.0 / 40320 + r2 * (-1.0 / 3628800 + r2 * (1.0 / 479001600.0))))));
        const int qi = ((int)q) & 3;
        const double c = qi == 0 ? cs : (qi == 1 ? -sn : (qi == 2 ? -cs : sn));
        const double s = qi == 0 ? sn : (qi == 1 ? cs : (qi == 2 ? -sn : -cs));
        ((float*)(P.ws + WS_COS))[e] = (float)c; ((float*)(P.ws + WS_SIN))[e] = (float)s;
    }
    if (blockIdx.x == 0) {
        const int d = tid;
        const float a0 = P.lb_logits[d], a1 = P.lb_logits[512 + d], a2 = P.lb_logits[1024 + d], a3 = P.lb_logits[1536 + d];
        const float mx = fmaxf(fmaxf(a0, a1), fmaxf(a2, a3));
        const float e0 = expf(a0 - mx), e1 = expf(a1 - mx), e2 = expf(a2 - mx), e3 = expf(a3 - mx);
        const float inv = 1.0f / (e0 + e1 + e2 + e3);
        float* lb = (float*)(P.ws + WS_LB);
        lb[d] = 0.f; lb[512 + d] = e1 * inv; lb[1024 + d] = (e1 + e2) * inv; lb[1536 + d] = (e1 + e2 + e3) * inv;
    }
}

#define MFMA16(a, b, c) __builtin_amdgcn_mfma_f32_16x16x32_bf16((a), (b), (c), 0, 0, 0)
__device__ __forceinline__ bf16x8 pack8(const f32x4 a, const f32x4 b) {
    u32x4 w; w.x = pk2(a.x, a.y); w.y = pk2(a.z, a.w); w.z = pk2(b.x, b.y); w.w = pk2(b.z, b.w);
    return __builtin_bit_cast(bf16x8, w);
}

template <int NQT, int NHALF, bool SAMPLE>
__device__ __forceinline__ void attn_unit(const Params& P, LAS unsigned char* lds, int layer, int unit) {
    int tid = threadIdx.x; asm volatile("" : "+v"(tid));
    const int wave = tid >> 6, lane = tid & 63, fr = lane & 15, g = lane >> 4;
    bf16_t* Z = (bf16_t*)(P.ws + WS_Z);
    LAS bf16_t* Ks = (LAS bf16_t*)lds;
    LAS bf16_t* VTs = (LAS bf16_t*)(lds + 55296);
    LAS float* red = (LAS float*)(lds + 106496);
    int row0, smin, smax;
    if (SAMPLE) { row0 = RP + unit * 8; smin = 0; smax = 136; }
    else { const int b = unit >> 5, qb = unit & 31; row0 = b * 2048 + qb * 64; smin = 128 - qb * 64; if (smin < 0) smin = 0; smax = 192; }
    __syncthreads();
    for (int ch = tid; ch < 3072; ch += 512) {
        const int c8 = ch & 7, s = (ch >> 3) % 192, kvh = ch / 1536;
        u32x4 kv = (u32x4){0u, 0u, 0u, 0u}, vv = (u32x4){0u, 0u, 0u, 0u};
        LAS bf16_t* kdst = Ks + (kvh * 192 + s) * 72;
        bool kdone = false;
        if (!SAMPLE) {
            if (s >= smin) { const size_t zr = (size_t)(row0 - 128 + s) * INC; kv = *(const u32x4*)(Z + zr + ZC_K + kvh * 64 + c8 * 8); vv = *(const u32x4*)(Z + zr + ZC_V + kvh * 64 + c8 * 8); }
        } else {
            if (s < 128) {
                const size_t co = ((((size_t)layer * 128 + unit) * 128 + s) * 2 + kvh) * 64 + c8 * 8;
                const f32x4 k0 = *(const f32x4*)(P.cache_k + co), k1 = *(const f32x4*)(P.cache_k + co + 4);
                const f32x4 v0 = *(const f32x4*)(P.cache_v + co), v1 = *(const f32x4*)(P.cache_v + co + 4);
                if (s >= 8) {
                    const size_t oo = ((((size_t)layer * 128 + unit) * 128 + (s - 8)) * 2 + kvh) * 64 + c8 * 8;
                    *(f32x4*)(P.out + O_KS + oo) = k0; *(f32x4*)(P.out + O_KS + oo + 4) = k1;
                    *(f32x4*)(P.out + O_VS + oo) = v0; *(f32x4*)(P.out + O_VS + oo + 4) = v1;
                }
                const int pb = (c8 < 4) ? (c8 * 16) : ((c8 - 4) * 16 + 1);
                kdst[pb + 0] = (bf16_t)(pk2(k0.x, 0.f) & 0xffffu); kdst[pb + 2] = (bf16_t)(pk2(k0.y, 0.f) & 0xffffu);
                kdst[pb + 4] = (bf16_t)(pk2(k0.z, 0.f) & 0xffffu); kdst[pb + 6] = (bf16_t)(pk2(k0.w, 0.f) & 0xffffu);
                kdst[pb + 8] = (bf16_t)(pk2(k1.x, 0.f) & 0xffffu); kdst[pb + 10] = (bf16_t)(pk2(k1.y, 0.f) & 0xffffu);
                kdst[pb + 12] = (bf16_t)(pk2(k1.z, 0.f) & 0xffffu); kdst[pb + 14] = (bf16_t)(pk2(k1.w, 0.f) & 0xffffu);
                kdone = true;
                vv.x = pk2(v0.x, v0.y); vv.y = pk2(v0.z, v0.w); vv.z = pk2(v1.x, v1.y); vv.w = pk2(v1.z, v1.w);
            } else if (s < 136) {
                const size_t zr = (size_t)(row0 + s - 128) * INC; kv = *(const u32x4*)(Z + zr + ZC_K + kvh * 64 + c8 * 8); vv = *(const u32x4*)(Z + zr + ZC_V + kvh * 64 + c8 * 8);
            }
        }
        if (!kdone) *(LAS u32x4*)(kdst + c8 * 8) = kv;
        LAS bf16_t* vdst = VTs + (kvh * 64 + c8 * 8) * 200 + s;
        vdst[0 * 200] = (bf16_t)(vv.x & 0xffffu); vdst[1 * 200] = (bf16_t)(vv.x >> 16);
        vdst[2 * 200] = (bf16_t)(vv.y & 0xffffu); vdst[3 * 200] = (bf16_t)(vv.y >> 16);
        vdst[4 * 200] = (bf16_t)(vv.z & 0xffffu); vdst[5 * 200] = (bf16_t)(vv.z >> 16);
        vdst[6 * 200] = (bf16_t)(vv.w & 0xffffu); vdst[7 * 200] = (bf16_t)(vv.w >> 16);
    }
    const int kvh = wave >> 2;
    const float sink = P.sinks[layer * 8 + wave] * 1.4426950408889634f;
    bf16_t* MIX = (bf16_t*)(P.ws + WS_MIX);
#pragma unroll 1
    for (int qh = 0; qh < NHALF; ++qh) {
    bf16x8 qf[NQT][2];
#pragma unroll
    for (int nt = 0; nt < NQT; ++nt)
#pragma unroll
        for (int ks = 0; ks < 2; ++ks) {
            int q = (qh * NQT + nt) * 16 + fr; if (SAMPLE && q > 7) q = 7;
            qf[nt][ks] = *(const bf16x8*)(Z + (size_t)(row0 + q) * INC + ZC_Q + wave * 64 + ks * 32 + g * 8);
        }
    f32x4 agv[4]; u32x4 asg[NQT][2];
#pragma unroll
    for (int pp = 0; pp < 2; ++pp) {
        const int c = wave * 64 + 32 * pp + 8 * g;
        agv[2 * pp] = *(const f32x4*)(P.attn_g + layer * 512 + c); agv[2 * pp + 1] = *(const f32x4*)(P.attn_g + layer * 512 + c + 4);
#pragma unroll
        for (int nt = 0; nt < NQT; ++nt) { int q = (qh * NQT + nt) * 16 + fr; if (SAMPLE && q > 7) q = 7; asg[nt][pp] = *(const u32x4*)(Z + (size_t)(row0 + q) * INC + ZC_GA + c); }
    }
    if (qh == 0) __syncthreads();

    float m_run[NQT], l_run[NQT];
    int dq[NQT];
    f32x4 ot[4][NQT];
#pragma unroll
    for (int nt = 0; nt < NQT; ++nt) { m_run[nt] = sink; l_run[nt] = 0.f; dq[nt] = (qh * NQT + nt) * 16 + fr - 8 * g;
#pragma unroll
        for (int dt = 0; dt < 4; ++dt) ot[dt][nt] = (f32x4){0.f, 0.f, 0.f, 0.f}; }
#pragma unroll
    for (int kb = 0; kb < 3; ++kb) {
        if (kb * 64 + 63 < smin) continue;
        f32x4 st[4][NQT];
#pragma unroll
        for (int kt = 0; kt < 4; ++kt) {
            const int key_r = kb * 64 + (kt >> 1) * 32 + 8 * (fr >> 2) + 4 * (kt & 1) + (fr & 3);
#pragma unroll
            for (int nt = 0; nt < NQT; ++nt) st[kt][nt] = (f32x4){0.f, 0.f, 0.f, 0.f};
#pragma unroll
            for (int ks = 0; ks < 2; ++ks) {
                const bf16x8 kf = *(const LAS bf16x8*)(Ks + (kvh * 192 + key_r) * 72 + ks * 32 + g * 8);
#pragma unroll
                for (int nt = 0; nt < NQT; ++nt) st[kt][nt] = MFMA16(kf, qf[nt][ks], st[kt][nt]);
            }
        }
#pragma unroll
        for (int nt = 0; nt < NQT; ++nt) {
            float mx = m_run[nt];
#pragma unroll
            for (int kt = 0; kt < 4; ++kt)
#pragma unroll
                for (int j = 0; j < 4; ++j) {
                    const int c = kb * 64 + (kt >> 1) * 32 + 4 * (kt & 1) + j;
                    float v = st[kt][nt][j];
                    if (kb == 0) v = (c > dq[nt]) ? v : -1e30f;
                    if (kb == 2) v = (c - 128 <= dq[nt]) ? v : -1e30f;
                    if (SAMPLE && kb == 2) v = (c + 8 * g < smax) ? v : -1e30f;
                    st[kt][nt][j] = v; mx = fmaxf(mx, v);
                }
            mx = fmaxf(mx, __shfl_xor(mx, 16)); mx = fmaxf(mx, __shfl_xor(mx, 32));
            const float alpha = __builtin_amdgcn_exp2f(m_run[nt] - mx); m_run[nt] = mx;
            float psum = 0.f;
#pragma unroll
            for (int kt = 0; kt < 4; ++kt)
#pragma unroll
                for (int j = 0; j < 4; ++j) { const float p = __builtin_amdgcn_exp2f(st[kt][nt][j] - mx); st[kt][nt][j] = p; psum += p; }
            l_run[nt] = l_run[nt] * alpha + psum;
#pragma unroll
            for (int dt = 0; dt < 4; ++dt) ot[dt][nt] = ot[dt][nt] * alpha;
        }
#pragma unroll
        for (int kg = 0; kg < 2; ++kg) {
            bf16x8 pf[NQT];
#pragma unroll
            for (int nt = 0; nt < NQT; ++nt) pf[nt] = pack8(st[2 * kg][nt], st[2 * kg + 1][nt]);
#pragma unroll
            for (int dt = 0; dt < 4; ++dt) {
                const bf16x8 vf = *(const LAS bf16x8*)(VTs + (kvh * 64 + 32 * (dt >> 1) + 8 * (fr >> 2) + 4 * (dt & 1) + (fr & 3)) * 200 + kb * 64 + kg * 32 + 8 * g);
#pragma unroll
                for (int nt = 0; nt < NQT; ++nt) ot[dt][nt] = MFMA16(vf, pf[nt], ot[dt][nt]);
            }
        }
    }
#pragma unroll
    for (int nt = 0; nt < NQT; ++nt) {
        float ls = l_run[nt]; ls += __shfl_xor(ls, 16); ls += __shfl_xor(ls, 32);
        const float inv = 1.0f / (ls + __builtin_amdgcn_exp2f(sink - m_run[nt]));
        float ssq = 0.f;
#pragma unroll
        for (int dt = 0; dt < 4; ++dt) { ot[dt][nt] = ot[dt][nt] * inv; const f32x4 o = ot[dt][nt]; ssq += (o.x * o.x + o.y * o.y) + (o.z * o.z + o.w * o.w); }
        ssq += __shfl_xor(ssq, 16); ssq += __shfl_xor(ssq, 32);
        if (g == 0) red[qh * 512 + wave * 64 + nt * 16 + fr] = ssq;
    }
    __syncthreads();
#pragma unroll
    for (int nt = 0; nt < NQT; ++nt) {
        const int q = (qh * NQT + nt) * 16 + fr;
        float tot = 0.f;
#pragma unroll
        for (int w = 0; w < 8; ++w) tot += red[qh * 512 + w * 64 + nt * 16 + fr];
        const float rs = rsqrtf(tot * (1.0f / 512.0f) + NORM_EPS);
        if (!SAMPLE || q < 8) {
            const size_t row = (size_t)(row0 + q);
#pragma unroll
            for (int pp = 0; pp < 2; ++pp) {
                const int c = wave * 64 + 32 * pp + 8 * g;
                const f32x4 g0 = agv[2 * pp], g1 = agv[2 * pp + 1];
                const u32x4 sg = asg[nt][pp];
                const f32x4 o0 = ot[2 * pp][nt], o1 = ot[2 * pp + 1][nt];
                u32x4 w;
                w.x = pk2(o0.x * rs * g0.x * bflo(sg.x), o0.y * rs * g0.y * bfhi(sg.x)); w.y = pk2(o0.z * rs * g0.z * bflo(sg.y), o0.w * rs * g0.w * bfhi(sg.y));
                w.z = pk2(o1.x * rs * g1.x * bflo(sg.z), o1.y * rs * g1.y * bfhi(sg.z)); w.w = pk2(o1.z * rs * g1.z * bflo(sg.w), o1.w * rs * g1.w * bfhi(sg.w));
                *(u32x4*)(MIX + row * DM + c) = w;
            }
        }
    }
    }
}

template <bool SAMPLE>
__device__ __forceinline__ void hgrn_unit(const Params& P, LAS unsigned char* lds, int layer, int unit) {
    int tid = threadIdx.x; asm volatile("" : "+v"(tid));
    const int wave = tid >> 6, lane = tid & 63, fr = lane & 15, g = lane >> 4;
    const int b = unit >> 2, h = unit & 3;
    bf16_t* Z = (bf16_t*)(P.ws + WS_Z);
    bf16_t* MIX = (bf16_t*)(P.ws + WS_MIX);
    LAS bf16_t* Qs = (LAS bf16_t*)lds;
    LAS bf16_t* Ks = (LAS bf16_t*)(lds + 17408);
    LAS bf16_t* KTs = (LAS bf16_t*)(lds + 34816);
    LAS bf16_t* VTs = (LAS bf16_t*)(lds + 53248);
    LAS bf16_t* STs = (LAS bf16_t*)(lds + 71680);
    LAS float* part = (LAS float*)(lds + 106496);
    LAS float* red = (LAS float*)(lds + 108544);
    constexpr int nchunk = SAMPLE ? 1 : 32;
    constexpr int tvalid = SAMPLE ? 8 : 64;
    const size_t rowbase = SAMPLE ? (size_t)(RP + b * 8) : (size_t)b * 2048;
    const int d = tid & 127, tq = tid >> 7;
    const int nt = wave & 3, vh = wave >> 2;
    unsigned short r_lf[16], r_q[16], r_v[16];
#pragma unroll
    for (int i = 0; i < 16; ++i) {
        const int t = tq * 16 + i;
        r_lf[i] = 0; r_q[i] = 0; r_v[i] = 0;
        if (SAMPLE && t < tvalid) { const bf16_t* zr = Z + (rowbase + t) * INC + h * 128 + d; r_lf[i] = zr[ZC_HF]; r_q[i] = zr[ZC_HQ]; r_v[i] = zr[ZC_HI]; }
    }
    f32x4 hgv[4]; u32x4 hsg[2];
    if (SAMPLE) {
        int t = nt * 16 + fr; if (t > tvalid - 1) t = tvalid - 1;
#pragma unroll
        for (int pp = 0; pp < 2; ++pp) {
            const int v0 = h * 128 + vh * 64 + 32 * pp + 8 * g;
            hgv[2 * pp] = *(const f32x4*)(P.hg_g + layer * 512 + v0); hgv[2 * pp + 1] = *(const f32x4*)(P.hg_g + layer * 512 + v0 + 4);
            hsg[pp] = *(const u32x4*)(Z + (rowbase + t) * INC + ZC_GH + v0);
        }
    }
    f32x4 sacc[8];
    if (SAMPLE) {
        const float* S0 = P.state + (((size_t)layer * 128 + b) * 4 + h) * 16384;
#pragma unroll
        for (int j = 0; j < 4; ++j) {
            const float* sp = S0 + (size_t)(16 * wave + 4 * g + j) * 128 + 8 * fr;
            const f32x4 a0 = *(const f32x4*)sp, a1 = *(const f32x4*)(sp + 4);
            sacc[0][j] = a0.x; sacc[1][j] = a0.y; sacc[2][j] = a0.z; sacc[3][j] = a0.w; sacc[4][j] = a1.x; sacc[5][j] = a1.y; sacc[6][j] = a1.z; sacc[7][j] = a1.w;
        }
    } else {
#pragma unroll
        for (int vt = 0; vt < 8; ++vt) sacc[vt] = (f32x4){0.f, 0.f, 0.f, 0.f};
    }
    __syncthreads();
#pragma unroll 1
    for (int c = 0; c < nchunk; ++c) {
        const size_t row0 = rowbase + (size_t)c * 64;
        float lf[16], qv[16];
        float loc = 0.f;
#pragma unroll
        for (int i = 0; i < 16; ++i) {
            const int t = tq * 16 + i;
            bf16_t vraw = 0; lf[i] = 0.f; qv[i] = 0.f;
            if (SAMPLE) { lf[i] = bf2f(r_lf[i]); qv[i] = bf2f(r_q[i]); vraw = r_v[i]; }
            else if (t < tvalid) {
                const bf16_t* zr = Z + (row0 + t) * INC + h * 128 + d;
                lf[i] = bf2f(zr[ZC_HF]); qv[i] = bf2f(zr[ZC_HQ]); vraw = zr[ZC_HI];
            }
            loc += lf[i];
            VTs[d * 72 + t] = vraw;
        }
        part[tq * 128 + d] = loc;
        __syncthreads();
        {
            const float p0 = part[d], p1 = part[128 + d], p2 = part[256 + d];
            const float gref = p0 + p1;
            float G = (tq > 0 ? p0 : 0.f) + (tq > 1 ? p1 : 0.f) + (tq > 2 ? p2 : 0.f);
#pragma unroll
            for (int i = 0; i < 16; ++i) {
                const int t = tq * 16 + i;
                G += lf[i];
                const float kk = 1.0f - __expf(lf[i]);
                const float eq = __expf(G - gref), ek = __expf(gref - G);
                const bf16_t qb = (bf16_t)(pk2(qv[i] * eq, 0.f) & 0xffffu);
                const bf16_t kb = (bf16_t)(pk2(kk * ek, 0.f) & 0xffffu);
                Qs[t * 136 + d] = qb; Ks[t * 136 + d] = kb; KTs[d * 72 + t] = kb;
            }
            float eg[4];
#pragma unroll
            for (int j = 0; j < 4; ++j) { const int dj = 16 * wave + 4 * g + j; eg[j] = __expf(part[dj] + part[128 + dj]); }
#pragma unroll
            for (int vt = 0; vt < 8; ++vt) {
#pragma unroll
                for (int j = 0; j < 4; ++j) sacc[vt][j] *= eg[j];
                u32x2 w; w.x = pk2(sacc[vt].x, sacc[vt].y); w.y = pk2(sacc[vt].z, sacc[vt].w);
                *(LAS u32x2*)(STs + (8 * fr + vt) * 136 + 16 * wave + 4 * g) = w;
            }
        }
        __syncthreads();
        bf16x8 qf[4];
#pragma unroll
        for (int ks = 0; ks < 4; ++ks) qf[ks] = *(const LAS bf16x8*)(Qs + (nt * 16 + fr) * 136 + ks * 32 + g * 8);
        bf16x8 pf[2];
#pragma unroll
        for (int sg = 0; sg < 2; ++sg) {
            f32x4 at0 = (f32x4){0.f, 0.f, 0.f, 0.f}, at1 = (f32x4){0.f, 0.f, 0.f, 0.f};
            if (sg * 32 <= nt * 16 + 15) {
                const int sr0 = sg * 32 + 8 * (fr >> 2) + (fr & 3), sr1 = sr0 + 4;
#pragma unroll
                for (int ks = 0; ks < 4; ++ks) {
                    const bf16x8 k0 = *(const LAS bf16x8*)(Ks + sr0 * 136 + ks * 32 + g * 8);
                    const bf16x8 k1 = *(const LAS bf16x8*)(Ks + sr1 * 136 + ks * 32 + g * 8);
                    at0 = MFMA16(k0, qf[ks], at0); at1 = MFMA16(k1, qf[ks], at1);
                }
                const int t = nt * 16 + fr;
#pragma unroll
                for (int j = 0; j < 4; ++j) {
                    const int s0 = sg * 32 + 8 * g + j, s1 = s0 + 4;
                    if (s0 > t) at0[j] = 0.f;
                    if (s1 > t) at1[j] = 0.f;
                }
            }
            pf[sg] = pack8(at0, at1);
        }
        f32x4 ot[4];
#pragma unroll
        for (int vi = 0; vi < 4; ++vi) {
            const int vrow = vh * 64 + 32 * (vi >> 1) + 8 * (fr >> 2) + 4 * (vi & 1) + (fr & 3);
            f32x4 o = (f32x4){0.f, 0.f, 0.f, 0.f};
#pragma unroll
            for (int sg = 0; sg < 2; ++sg) {
                if (sg * 32 <= nt * 16 + 15) {
                    const bf16x8 vf = *(const LAS bf16x8*)(VTs + vrow * 72 + sg * 32 + 8 * g);
                    o = MFMA16(vf, pf[sg], o);
                }
            }
#pragma unroll
            for (int ks = 0; ks < 4; ++ks) {
                const bf16x8 sf = *(const LAS bf16x8*)(STs + vrow * 136 + ks * 32 + 8 * g);
                o = MFMA16(sf, qf[ks], o);
            }
            ot[vi] = o;
        }
#pragma unroll
        for (int ks = 0; ks < 2; ++ks) {
            const bf16x8 ktf = *(const LAS bf16x8*)(KTs + (16 * wave + fr) * 72 + ks * 32 + 8 * g);
#pragma unroll
            for (int vt = 0; vt < 8; ++vt) {
                const bf16x8 vf = *(const LAS bf16x8*)(VTs + (8 * fr + vt) * 72 + ks * 32 + 8 * g);
                sacc[vt] = MFMA16(ktf, vf, sacc[vt]);
            }
        }
        {
            float el[4];
#pragma unroll
            for (int j = 0; j < 4; ++j) { const int dj = 16 * wave + 4 * g + j; el[j] = __expf(part[256 + dj] + part[384 + dj]); }
#pragma unroll
            for (int vt = 0; vt < 8; ++vt)
#pragma unroll
                for (int j = 0; j < 4; ++j) sacc[vt][j] *= el[j];
        }
        float ssq = 0.f;
#pragma unroll
        for (int vi = 0; vi < 4; ++vi) { const f32x4 o = ot[vi]; ssq += (o.x * o.x + o.y * o.y) + (o.z * o.z + o.w * o.w); }
        ssq += __shfl_xor(ssq, 16); ssq += __shfl_xor(ssq, 32);
        if (g == 0) red[vh * 64 + nt * 16 + fr] = ssq;
        __syncthreads();
        {
            const int t = nt * 16 + fr;
            const float tot = red[t] + red[64 + t];
            const float rs = rsqrtf(tot * (1.0f / 128.0f) + NORM_EPS);
            if (t < tvalid) {
                const size_t row = row0 + t;
#pragma unroll
                for (int pp = 0; pp < 2; ++pp) {
                    const int v0 = h * 128 + vh * 64 + 32 * pp + 8 * g;
                    f32x4 g0, g1; u32x4 sg;
                    if (SAMPLE) { g0 = hgv[2 * pp]; g1 = hgv[2 * pp + 1]; sg = hsg[pp]; }
                    else { g0 = *(const f32x4*)(P.hg_g + layer * 512 + v0); g1 = *(const f32x4*)(P.hg_g + layer * 512 + v0 + 4); sg = *(const u32x4*)(Z + row * INC + ZC_GH + v0); }
                    const f32x4 o0 = ot[2 * pp], o1 = ot[2 * pp + 1];
                    u32x4 w;
                    w.x = pk2(o0.x * rs * g0.x * bflo(sg.x), o0.y * rs * g0.y * bfhi(sg.x)); w.y = pk2(o0.z * rs * g0.z * bflo(sg.y), o0.w * rs * g0.w * bfhi(sg.y));
                    w.z = pk2(o1.x * rs * g1.x * bflo(sg.z), o1.y * rs * g1.y * bfhi(sg.z)); w.w = pk2(o1.z * rs * g1.z * bflo(sg.w), o1.w * rs * g1.w * bfhi(sg.w));
                    *(u32x4*)(MIX + row * DM + 512 + v0) = w;
                }
            }
        }
    }
    float* So = SAMPLE ? P.out + O_SS + (((size_t)layer * 128 + b) * 4 + h) * 16384 : P.out + O_SP + (((size_t)layer * 8 + b) * 4 + h) * 16384;
#pragma unroll
    for (int j = 0; j < 4; ++j) {
        float* sp = So + (size_t)(16 * wave + 4 * g + j) * 128 + 8 * fr;
        *(f32x4*)sp = (f32x4){sacc[0][j], sacc[1][j], sacc[2][j], sacc[3][j]};
        *(f32x4*)(sp + 4) = (f32x4){sacc[4][j], sacc[5][j], sacc[6][j], sacc[7][j]};
    }
}


template <int MODE>
__device__ __forceinline__ int hgrn_chunk_loop(const Params& P, LAS unsigned char* lds, int layer, int u0, int lo, int hi, unsigned* ctr, int qbase, LAS unsigned* slot) {
    int tid = threadIdx.x; asm volatile("" : "+v"(tid));
    const int wave = tid >> 6, lane = tid & 63, fr = lane & 15, g = lane >> 4;
    bf16_t* Z = (bf16_t*)(P.ws + WS_Z);
    bf16_t* MIX = (bf16_t*)(P.ws + WS_MIX);
    LAS bf16_t* Qs = (LAS bf16_t*)lds;
    LAS bf16_t* Ks = (LAS bf16_t*)(lds + 17408);
    LAS bf16_t* KTs = (LAS bf16_t*)(lds + 34816);
    LAS bf16_t* VTs = (LAS bf16_t*)(lds + 53248);
    LAS bf16_t* STs = (LAS bf16_t*)(lds + 71680);
    LAS float* part = (LAS float*)(lds + 106496);
    LAS float* red = (LAS float*)(lds + 108544);
    const int d = tid & 127, tq = tid >> 7;
    const int nt = wave & 3, vh = wave >> 2;
    unsigned short rlf[16], rq[16], rv[16];
#define HG_LOAD_RAW(unit_) do { const int _bh = (unit_) >> 5, _c = (unit_) & 31; \
        const bf16_t* _zr = Z + ((size_t)(_bh >> 2) * 2048 + (size_t)_c * 64 + tq * 16) * INC + (_bh & 3) * 128 + d; \
        _Pragma("unroll") for (int i = 0; i < 16; ++i) { rlf[i] = _zr[(size_t)i * INC + ZC_HF]; if (MODE == 1) rq[i] = _zr[(size_t)i * INC + ZC_HQ]; rv[i] = _zr[(size_t)i * INC + ZC_HI]; } } while (0)
    int unit = u0 - lo;
    HG_LOAD_RAW(unit);
    u32x4 stv[4];
#define HG_LOAD_ST(unit_) do { const bf16_t* _st = (const bf16_t*)(P.ws + WS_ST) + (size_t)(unit_) * 16384; \
        _Pragma("unroll") for (int k = 0; k < 4; ++k) { const int _i = tid + 512 * k; stv[k] = *(const u32x4*)(_st + (_i >> 4) * 128 + (_i & 15) * 8); } } while (0)
    if (MODE == 1) HG_LOAD_ST(unit);
#pragma unroll 1
    for (;;) {
        const int bh = unit >> 5, c = unit & 31, b = bh >> 2, h = bh & 3;
        const size_t row0 = (size_t)b * 2048 + (size_t)c * 64;
        u32x4 sgv[2]; f32x4 gvv[4];
        if (MODE == 1) {
#pragma unroll
            for (int pp = 0; pp < 2; ++pp) {
                const int v0 = h * 128 + vh * 64 + 32 * pp + 8 * g;
                gvv[2 * pp] = *(const f32x4*)(P.hg_g + layer * 512 + v0); gvv[2 * pp + 1] = *(const f32x4*)(P.hg_g + layer * 512 + v0 + 4);
                sgv[pp] = *(const u32x4*)(Z + (row0 + nt * 16 + fr) * INC + ZC_GH + v0);
            }
        }
        __syncthreads();
        unsigned popped = 0u;
        if (tid == 0) popped = __hip_atomic_fetch_add(ctr, 1u, __ATOMIC_RELAXED, __HIP_MEMORY_SCOPE_AGENT);
        float lf[16], qv[16];
        float loc = 0.f;
#pragma unroll
        for (int i = 0; i < 16; ++i) {
            const int t = tq * 16 + i;
            lf[i] = bf2f(rlf[i]); qv[i] = (MODE == 1) ? bf2f(rq[i]) : 0.f;
            loc += lf[i];
            VTs[d * 72 + t] = rv[i];
        }
        part[tq * 128 + d] = loc;
        if (tid == 0) slot[0] = (unsigned)qbase + popped;
        __syncthreads();
        const int nu = (int)slot[0];
        const bool more = (nu >= lo) && (nu < hi);
        {
            const float p0 = part[d], p1 = part[128 + d], p2 = part[256 + d];
            const float gref = p0 + p1;
            float G = (tq > 0 ? p0 : 0.f) + (tq > 1 ? p1 : 0.f) + (tq > 2 ? p2 : 0.f);
#pragma unroll
            for (int i = 0; i < 16; ++i) {
                const int t = tq * 16 + i;
                G += lf[i];
                const float kk = 1.0f - __expf(lf[i]);
                const float ek = __expf(gref - G);
                const bf16_t kb = (bf16_t)(pk2(kk * ek, 0.f) & 0xffffu);
                if (MODE == 0) KTs[d * 72 + t] = kb;
                else {
                    const float eq = __expf(G - gref);
                    Ks[t * 136 + d] = kb; Qs[t * 136 + d] = (bf16_t)(pk2(qv[i] * eq, 0.f) & 0xffffu);
                }
            }
            if (MODE == 1) {
#pragma unroll
                for (int k = 0; k < 4; ++k) { const int i = tid + 512 * k; *(LAS u32x4*)(STs + (i >> 4) * 136 + (i & 15) * 8) = stv[k]; }
            }
            if (MODE == 0 && tq == 0) {
                float* DV = (float*)(P.ws + WS_DV) + (size_t)unit * 256;
                DV[d] = __expf(gref + p2 + part[384 + d]); DV[128 + d] = __expf(gref);
            }
        }
        __syncthreads();
        if (more) { HG_LOAD_RAW(nu - lo); if (MODE == 1) HG_LOAD_ST(nu - lo); }
        if (MODE == 0) {
            f32x4 sacc[8];
#pragma unroll
            for (int vt = 0; vt < 8; ++vt) sacc[vt] = (f32x4){0.f, 0.f, 0.f, 0.f};
#pragma unroll
            for (int ks = 0; ks < 2; ++ks) {
                const bf16x8 ktf = *(const LAS bf16x8*)(KTs + (16 * wave + fr) * 72 + ks * 32 + 8 * g);
#pragma unroll
                for (int vt = 0; vt < 8; ++vt) {
                    const bf16x8 vf = *(const LAS bf16x8*)(VTs + (vt * 16 + fr) * 72 + ks * 32 + 8 * g);
                    sacc[vt] = MFMA16(ktf, vf, sacc[vt]);
                }
            }
            float el[4];
#pragma unroll
            for (int j = 0; j < 4; ++j) { const int dj = 16 * wave + 4 * g + j; el[j] = __expf(part[256 + dj] + part[384 + dj]); }
            bf16_t* UT = (bf16_t*)(P.ws + WS_U) + (size_t)unit * 16384;
#pragma unroll
            for (int vt = 0; vt < 8; ++vt) {
                f32x4 o; o.x = sacc[vt].x * el[0]; o.y = sacc[vt].y * el[1]; o.z = sacc[vt].z * el[2]; o.w = sacc[vt].w * el[3];
                u32x2 uw; uw.x = pk2(o.x, o.y); uw.y = pk2(o.z, o.w);
                *(u32x2*)(UT + (vt * 16 + fr) * 128 + 16 * wave + 4 * g) = uw;
            }
        } else {
            bf16x8 qf[4];
#pragma unroll
            for (int ks = 0; ks < 4; ++ks) qf[ks] = *(const LAS bf16x8*)(Qs + (nt * 16 + fr) * 136 + ks * 32 + g * 8);
            bf16x8 pf[2];
#pragma unroll
            for (int sg = 0; sg < 2; ++sg) {
                f32x4 at0 = (f32x4){0.f, 0.f, 0.f, 0.f}, at1 = (f32x4){0.f, 0.f, 0.f, 0.f};
                if (sg * 32 <= nt * 16 + 15) {
                    const int sr0 = sg * 32 + 8 * (fr >> 2) + (fr & 3), sr1 = sr0 + 4;
#pragma unroll
                    for (int ks = 0; ks < 4; ++ks) {
                        const bf16x8 k0 = *(const LAS bf16x8*)(Ks + sr0 * 136 + ks * 32 + g * 8);
                        const bf16x8 k1 = *(const LAS bf16x8*)(Ks + sr1 * 136 + ks * 32 + g * 8);
                        at0 = MFMA16(k0, qf[ks], at0); at1 = MFMA16(k1, qf[ks], at1);
                    }
                    const int t = nt * 16 + fr;
#pragma unroll
                    for (int j = 0; j < 4; ++j) {
                        const int s0 = sg * 32 + 8 * g + j, s1 = s0 + 4;
                        if (s0 > t) at0[j] = 0.f;
                        if (s1 > t) at1[j] = 0.f;
                    }
                }
                pf[sg] = pack8(at0, at1);
            }
            f32x4 ot[4];
#pragma unroll
            for (int vi = 0; vi < 4; ++vi) {
                const int vrow = vh * 64 + 32 * (vi >> 1) + 8 * (fr >> 2) + 4 * (vi & 1) + (fr & 3);
                f32x4 o = (f32x4){0.f, 0.f, 0.f, 0.f};
#pragma unroll
                for (int sg = 0; sg < 2; ++sg) {
                    if (sg * 32 <= nt * 16 + 15) {
                        const bf16x8 vf = *(const LAS bf16x8*)(VTs + vrow * 72 + sg * 32 + 8 * g);
                        o = MFMA16(vf, pf[sg], o);
                    }
                }
#pragma unroll
                for (int ks = 0; ks < 4; ++ks) {
                    const bf16x8 sf = *(const LAS bf16x8*)(STs + vrow * 136 + ks * 32 + 8 * g);
                    o = MFMA16(sf, qf[ks], o);
                }
                ot[vi] = o;
            }
            float ssq = 0.f;
#pragma unroll
            for (int vi = 0; vi < 4; ++vi) { const f32x4 o = ot[vi]; ssq += (o.x * o.x + o.y * o.y) + (o.z * o.z + o.w * o.w); }
            ssq += __shfl_xor(ssq, 16); ssq += __shfl_xor(ssq, 32);
            if (g == 0) red[vh * 64 + nt * 16 + fr] = ssq;
            __syncthreads();
            const int t = nt * 16 + fr;
            const float tot = red[t] + red[64 + t];
            const float rs = rsqrtf(tot * (1.0f / 128.0f) + NORM_EPS);
            const size_t row = row0 + t;
#pragma unroll
            for (int pp = 0; pp < 2; ++pp) {
                const int v0 = h * 128 + vh * 64 + 32 * pp + 8 * g;
                const f32x4 g0 = gvv[2 * pp], g1 = gvv[2 * pp + 1]; const u32x4 sg = sgv[pp];
                const f32x4 o0 = ot[2 * pp], o1 = ot[2 * pp + 1];
                u32x4 w;
                w.x = pk2(o0.x * rs * g0.x * bflo(sg.x), o0.y * rs * g0.y * bfhi(sg.x)); w.y = pk2(o0.z * rs * g0.z * bflo(sg.y), o0.w * rs * g0.w * bfhi(sg.y));
                w.z = pk2(o1.x * rs * g1.x * bflo(sg.z), o1.y * rs * g1.y * bfhi(sg.z)); w.w = pk2(o1.z * rs * g1.z * bflo(sg.w), o1.w * rs * g1.w * bfhi(sg.w));
                *(u32x4*)(MIX + row * DM + 512 + v0) = w;
            }
        }
        if (!more) return nu;
        unit = nu - lo;
    }
#undef HG_LOAD_RAW
#undef HG_LOAD_ST
}

__device__ __forceinline__ void hgrn_scan(const Params& P, LAS unsigned char* lds, int layer, int unit) {
    int tid = threadIdx.x; asm volatile("" : "+v"(tid));
    const int bh = unit >> 3, prt = unit & 7;
    const int v = prt * 16 + (tid >> 5), d0 = (tid & 31) * 4;
    const bf16_t* UT = (const bf16_t*)(P.ws + WS_U) + (size_t)bh * 32 * 16384 + v * 128 + d0;
    bf16_t* ST = (bf16_t*)(P.ws + WS_ST) + (size_t)bh * 32 * 16384 + v * 128 + d0;
    const float* DV = (const float*)(P.ws + WS_DV) + (size_t)bh * 32 * 256;
    LAS float* DVs = (LAS float*)lds;
    u32x2 Uw[32];
#pragma unroll
    for (int c = 0; c < 32; ++c) Uw[c] = *(const u32x2*)(UT + (size_t)c * 16384);
    f32x4 dvr[4];
#pragma unroll
    for (int k = 0; k < 4; ++k) dvr[k] = *(const f32x4*)(DV + (size_t)(tid + 512 * k) * 4);
    __syncthreads();
#pragma unroll
    for (int k = 0; k < 4; ++k) *(LAS f32x4*)(DVs + (tid + 512 * k) * 4) = dvr[k];
    __syncthreads();
    f32x4 S = (f32x4){0.f, 0.f, 0.f, 0.f};
#pragma unroll
    for (int c = 0; c < 32; ++c) {
        const f32x4 Dv = *(const LAS f32x4*)(DVs + c * 256 + d0), Ev = *(const LAS f32x4*)(DVs + c * 256 + 128 + d0);
        const f32x4 sp = S * Ev;
        u32x2 w; w.x = pk2(sp.x, sp.y); w.y = pk2(sp.z, sp.w);
        *(u32x2*)(ST + (size_t)c * 16384) = w;
        S = S * Dv + (f32x4){bflo(Uw[c].x), bfhi(Uw[c].x), bflo(Uw[c].y), bfhi(Uw[c].y)};
    }
    float* So = P.out + O_SP + ((size_t)layer * 32 + bh) * 16384;
    So[(size_t)(d0 + 0) * 128 + v] = S.x; So[(size_t)(d0 + 1) * 128 + v] = S.y; So[(size_t)(d0 + 2) * 128 + v] = S.z; So[(size_t)(d0 + 3) * 128 + v] = S.w;
}

__device__ __forceinline__ int first_at_least(int blk, int G, int lo) { int u = blk; if (u < lo) u += ((lo - u + G - 1) / G) * G; return u; }
__device__ __forceinline__ void mixer_pass(const Params& P, LAS unsigned char* lds, int layer, int pass) {
    int G = gridDim.x, blk = blockIdx.x; asm volatile("" : "+s"(G), "+s"(blk));
    unsigned* ctr = (unsigned*)(P.ws + WS_BAR) + 3584 + 16 * (layer * 3 + pass);
    LAS unsigned* slot = (LAS unsigned*)(lds + 131072 + 64);
    const int nx = (pass > 0 && G >= 64) ? 16 : 0;
    const int qbase = G - nx;
    const int n = pass == 0 ? 1664 : (pass == 1 ? 496 : 1040);
    const int tid = threadIdx.x;
    int u;
    if (blk >= nx) u = blk - nx;
    else {
        __syncthreads();
        if (tid == 0) slot[0] = (unsigned)qbase + __hip_atomic_fetch_add(ctr, 1u, __ATOMIC_RELAXED, __HIP_MEMORY_SCOPE_AGENT);
        __syncthreads();
        u = (int)slot[0];
    }
#pragma unroll 1
    while (u < n) {
        if (pass == 0 && u >= 640) { u = hgrn_chunk_loop<0>(P, lds, layer, u, 640, 1664, ctr, qbase, slot); continue; }
        if (pass == 2 && u >= 16) { u = hgrn_chunk_loop<1>(P, lds, layer, u, 16, 1040, ctr, qbase, slot); continue; }
        __syncthreads();
        unsigned popped = 0u;
        if (tid == 0) popped = __hip_atomic_fetch_add(ctr, 1u, __ATOMIC_RELAXED, __HIP_MEMORY_SCOPE_AGENT);
        if (pass == 0) { if (u >= 128) { _Pragma("unroll 1") for (int r = 0; r < DUP_HS; ++r) hgrn_unit<true>(P, lds, layer, u - 128); } else attn_unit<1, 1, true>(P, lds, layer, u); }
        else if (pass == 1) { if (u < 240) { _Pragma("unroll 1") for (int r = 0; r < DUP_ATTN; ++r) attn_unit<2, 2, false>(P, lds, layer, (u & 7) * 30 + (u >> 3)); }     else { _Pragma("unroll 1") for (int r = 0; r < DUP_SCAN; ++r) hgrn_scan(P, lds, layer, u - 240); } }
        else { _Pragma("unroll 1") for (int r = 0; r < DUP_ATTN; ++r) attn_unit<2, 2, false>(P, lds, layer, 240 + u); }
        if (tid == 0) slot[0] = (unsigned)qbase + popped;
        __syncthreads();
        u = (int)slot[0];
    }
}

#define XB_TMO      128
#define XB_XCNT(j)  (256  + 64 * (j))
#define XB_XSUB(j)  (1280 + 64 * (j))
#define XB_XGEN(j)  (2304 + 64 * (j))
#define XB_TOP      3328
#define XB_TOPGEN   3392
#define XCD_BAR_WORDS 3456
#define XB_SPIN_CAP (1u << 20)
__device__ __forceinline__ unsigned xb_ld(unsigned* p)              { return __hip_atomic_load(p, __ATOMIC_RELAXED, __HIP_MEMORY_SCOPE_AGENT); }
__device__ __forceinline__ unsigned xb_add(unsigned* p, unsigned v) { return __hip_atomic_fetch_add(p, v, __ATOMIC_RELAXED, __HIP_MEMORY_SCOPE_AGENT); }
__device__ __forceinline__ unsigned xb_xcc_id() { return (unsigned)__builtin_amdgcn_s_getreg((3 << 11) | 20) & 0xFu; }
#define XB_SPIN(cond, bar) do { unsigned _sp = 0; while (cond) { __builtin_amdgcn_s_sleep(1); \
    if ((++_sp & 255u) == 0u) { if (xb_ld(&(bar)[XB_TMO])) break; if (_sp > XB_SPIN_CAP) { atomicAdd(&(bar)[XB_TMO], 1u); break; } } } } while (0)
struct XcdBarrier { unsigned* bar; unsigned x; volatile LAS unsigned* st; };
__device__ __forceinline__ XcdBarrier xcd_barrier_post(unsigned* bar, volatile LAS unsigned* st) {
    XcdBarrier b; b.bar = bar; b.x = xb_xcc_id(); b.st = st;
    if (threadIdx.x == 0) (void)xb_add(&bar[XB_XCNT(b.x)], 1u);
    return b;
}
__device__ __forceinline__ void xcd_barrier_complete(unsigned* bar, unsigned x, unsigned& nloc, unsigned& nx) {
    const unsigned G = gridDim.x * gridDim.y * gridDim.z;
    unsigned sum, cnt, mine, sp = 0u;
    for (;;) {
        sum = 0u; cnt = 0u; mine = 0u;
#pragma unroll
        for (unsigned j = 0; j < 16; ++j) { const unsigned c = xb_ld(&bar[XB_XCNT(j)]); sum += c; cnt += (c > 0u) ? 1u : 0u; mine = (j == x) ? c : mine; }
        if (sum == G) break;
        __builtin_amdgcn_s_sleep(1);
        if ((++sp & 255u) == 0u) { if (xb_ld(&bar[XB_TMO])) break; if (sp > XB_SPIN_CAP) { atomicAdd(&bar[XB_TMO], 1u); break; } }
    }
    nloc = mine > 0u ? mine : 1u; nx = cnt > 0u ? cnt : 1u;
}
__device__ __forceinline__ void xcd_barrier(const XcdBarrier& b) {
    asm volatile("s_waitcnt vmcnt(0)" ::: "memory");
    __syncthreads();
    if (threadIdx.x == 0) {
        unsigned* bar = b.bar;
        __builtin_amdgcn_s_waitcnt(0);
        unsigned nloc = b.st[0], nx = b.st[1];
        if (nloc == 0u) { xcd_barrier_complete(bar, b.x, nloc, nx); b.st[0] = nloc; b.st[1] = nx; }
        const unsigned old = xb_add(&bar[XB_XSUB(b.x)], 1u);
        const unsigned gen = old / nloc;
        if (old + 1u == (gen + 1u) * nloc) {
            __builtin_amdgcn_fence(__ATOMIC_RELEASE, "agent");
            asm volatile("s_waitcnt vmcnt(0)" ::: "memory");
            const unsigned og = xb_add(&bar[XB_TOP], 1u);
            const unsigned tg = og / nx;
            if (og + 1u == (tg + 1u) * nx) xb_add(&bar[XB_TOPGEN], 1u);
            else XB_SPIN(xb_ld(&bar[XB_TOPGEN]) == tg, bar);
            __builtin_amdgcn_fence(__ATOMIC_ACQUIRE, "agent");
            xb_add(&bar[XB_XGEN(b.x)], 1u);
            asm volatile("s_waitcnt vmcnt(0)" ::: "memory");
        } else {
            XB_SPIN(xb_ld(&bar[XB_XGEN(b.x)]) == gen, bar);
            __builtin_amdgcn_fence(__ATOMIC_ACQUIRE, "agent");
            asm volatile("s_waitcnt vmcnt(0)" ::: "memory");
        }
    }
    __syncthreads();
}

#define GSYNC() do { _Pragma("unroll 1") for (int _r = 0; _r < DUP_SYNC; ++_r) xcd_barrier(xb); } while (0)
__global__ void __launch_bounds__(512, 2) fwd_megakernel(Params P) {
    extern __shared__ __attribute__((aligned(16))) unsigned char shm[];
    LAS unsigned char* lds = (LAS unsigned char*)shm;
    cg::grid_group grid = cg::this_grid();
    if (threadIdx.x < 4) ((LAS unsigned*)(lds + 131072))[threadIdx.x] = 0u;
    __syncthreads();
    XcdBarrier xb = xcd_barrier_post((unsigned*)(P.ws + WS_BAR), (volatile LAS unsigned*)(lds + 131072));
    if (P.out == nullptr) grid.sync();
#pragma unroll 1
    for (int rep = 0; rep < DUP_PRO; ++rep) { prologue(P, lds); __syncthreads(); }
    GSYNC();
    if (blockIdx.x == gridDim.x - 1) {
        const float* cp = (const float*)(P.ws + WS_CP);
        for (int idx = threadIdx.x; idx < 8192; idx += 512) {
            const int l = idx >> 11, which = (idx >> 10) & 1, n = idx & 1023;
            float a = 0.f;
#pragma unroll
            for (int kb = 0; kb < 16; ++kb) a += cp[(size_t)l * 32768 + kb * 2048 + which * 1024 + n];
            ((float*)(P.ws + (which ? WS_C2 : WS_C1)))[l * 1024 + n] = a;
        }
    }
#pragma unroll 1
    for (int l = 0; l < NLAYER; ++l) {
#pragma unroll 1
        for (int stg = 0; stg < 6; ++stg) {
            int G = gridDim.x, blk = blockIdx.x; asm volatile("" : "+s"(G), "+s"(blk));
            const int nx = G >= 64 ? 16 : 0;
#pragma unroll 1
            for (int rep = 0; rep <= ((DUP_STG >> stg) & 1); ++rep) {
            if (rep) __syncthreads();
            if (stg == 0) {
                pg8::Gemm g{(const bf16_t*)(P.ws + WS_XB), (const bf16_t*)(P.ws + WS_WIN) + (size_t)l * INC * 1024, R, INC, 1024};
                pg8::StaticOrder S; S.init(R, INC, G, blk);
                EpiIn E{(bf16_t*)(P.ws + WS_Z), (const float*)(P.ws + WS_COS), (const float*)(P.ws + WS_SIN), (const float*)(P.ws + WS_LB) + l * 512,
                        P.out + O_KP + (size_t)l * 8 * 128 * 128, P.out + O_VP + (size_t)l * 8 * 128 * 128,
                        P.out + O_KS + (size_t)l * 128 * 128 * 128, P.out + O_VS + (size_t)l * 128 * 128 * 128};
                pg8::gemm_phase(lds, g, S, E);
                const int rem = 884 - (884 / G) * G;
                pg8::Gemm g2{(const bf16_t*)(P.ws + WS_PB) + (size_t)l * R * 256, (const bf16_t*)(P.ws + WS_WPP) + (size_t)l * 1024 * 256, R, 1024, 256};
                pg8::StaticOrder S2; S2.init(R, 1024, G - rem, blk >= rem ? blk - rem : (1 << 20));
                EpiPle E2{(bf16_t*)(P.ws + WS_PLE)};
                pg8::gemm_phase(lds, g2, S2, E2);
            }
            if (stg == 2 || stg == 4) {
                const bool smp = (stg == 2);
                const int Mrows = nx ? (smp ? RS : RP) : (smp ? 0 : R);
                const size_t r0 = (nx && smp) ? (size_t)RP : 0;
                pg8::Gemm g{(const bf16_t*)(P.ws + WS_MIX) + r0 * 1024, (const bf16_t*)(P.ws + WS_WOUT) + (size_t)l * 1024 * 1024, Mrows, 1024, 1024};
                pg8::StaticOrder S; S.init(Mrows, 1024, smp ? (nx ? nx : 1) : G, (smp && blk >= nx) ? (1 << 20) : blk);
                EpiOut E{l == 0 ? P.x_prompt : nullptr, l == 0 ? P.x_sample : nullptr, (const bf16_t*)(P.ws + WS_XB),
                         (bf16_t*)(P.ws + WS_PREB), (f32x2*)(P.ws + WS_STAT), (int)(r0 >> 8)};
                pg8::gemm_phase(lds, g, S, E);
            }
            if (stg == 3 || stg == 5) {
                const bool smp = (stg == 3);
                const int Mrows = nx ? (smp ? RS : RP) : (smp ? 0 : R);
                const size_t r0 = (nx && smp) ? (size_t)RP : 0;
                pg8::Gemm g{(const bf16_t*)(P.ws + WS_PREB) + r0 * 1024, (const bf16_t*)(P.ws + WS_WPG) + (size_t)l * 1024 * 1024, Mrows, 1024, 1024};
                pg8::StaticOrder S; S.init(Mrows, 1024, smp ? (nx ? nx : 1) : G, (smp && blk >= nx) ? (1 << 20) : blk);
                EpiGate E{(const bf16_t*)(P.ws + WS_PREB), (const f32x2*)(P.ws + WS_STAT), (const bf16_t*)(P.ws + WS_PLE),
                          (const float*)(P.ws + WS_C1) + l * 1024, (const float*)(P.ws + WS_C2) + l * 1024, P.ln_g + l * 1024, P.ln_b + l * 1024,
                          l == NLAYER - 1 ? P.out + O_Y : nullptr, l == NLAYER - 1 ? (bf16_t*)nullptr : (bf16_t*)(P.ws + WS_XB), (LAS f32x2*)(lds + 131072 + 1024), (int)(r0 >> 8)};
                pg8::gemm_phase(lds, g, S, E);
            }
            if (stg >= 1 && stg <= 3) mixer_pass(P, lds, l, stg - 1);
            }
            if (!(l == NLAYER - 1 && stg == 5)) GSYNC();
        }
    }
}

extern "C" void kernel_launch(void* const* d_in, const int* in_sizes, int n_in, void* d_out, int out_size, void* d_ws, size_t ws_size, hipStream_t stream) {
    static int grid = 0;
    if (grid == 0) {
        if (n_in != 17 || ws_size < WS_END) { fprintf(stderr, "kernel_launch: unexpected n_in %d or ws %zu < %zu\n", n_in, ws_size, (size_t)WS_END); grid = -1; return; }
        int dev = 0, cus = 0, per_cu = 0;
        hipGetDevice(&dev);
        hipDeviceGetAttribute(&cus, hipDeviceAttributeMultiprocessorCount, dev);
        if (hipFuncSetAttribute((const void*)fwd_megakernel, hipFuncAttributeMaxDynamicSharedMemorySize, LDS_BYTES) != hipSuccess) { fprintf(stderr, "kernel_launch: hipFuncSetAttribute failed\n"); grid = -1; return; }
        if (hipOccupancyMaxActiveBlocksPerMultiprocessor(&per_cu, (const void*)fwd_megakernel, 512, LDS_BYTES) != hipSuccess || per_cu < 1) { fprintf(stderr, "kernel_launch: occupancy query says %d\n", per_cu); (void)hipGetLastError(); per_cu = 1; }
        grid = cus * 1;
    }
    if (grid < 0) return;
    Params p{};
    p.x_prompt = (const float*)d_in[0]; p.x_sample = (const float*)d_in[1]; p.cache_k = (const float*)d_in[2]; p.cache_v = (const float*)d_in[3];
    p.state = (const float*)d_in[4]; p.p_prompt = (const float*)d_in[5]; p.p_sample = (const float*)d_in[6]; p.w_in = (const float*)d_in[7];
    p.sinks = (const float*)d_in[8]; p.attn_g = (const float*)d_in[9]; p.lb_logits = (const float*)d_in[10]; p.hg_g = (const float*)d_in[11];
    p.w_out = (const float*)d_in[12]; p.ln_g = (const float*)d_in[13]; p.ln_b = (const float*)d_in[14]; p.w_pp = (const float*)d_in[15]; p.w_pg = (const float*)d_in[16];
    p.out = (float*)d_out; p.ws = (unsigned char*)d_ws;
    if (hipMemsetAsync((char*)d_ws + WS_BAR, 0, 16384, stream) != hipSuccess) { fprintf(stderr, "kernel_launch: hipMemsetAsync failed\n"); return; }
    void* args[] = {&p};
    hipError_t e = hipLaunchCooperativeKernel((const void*)fwd_megakernel, dim3(grid), dim3(512), args, LDS_BYTES, stream);
    if (e != hipSuccess) fprintf(stderr, "cooperative launch failed: %s (grid %d)\n", hipGetErrorString(e), grid);
}
```

```cpp
#include <hip/hip_runtime.h>
#include <hip/hip_cooperative_groups.h>
#include <cstdio>
#include <cstdint>
namespace cg = cooperative_groups;
#ifndef DUP_PRO
#define DUP_PRO 1
#endif
#ifndef DUP_GIN
#define DUP_GIN 1
#endif
#ifndef DUP_MIX
#define DUP_MIX 1
#endif
#ifndef DUP_GOUT
#define DUP_GOUT 1
#endif
#ifndef DUP_GGATE
#define DUP_GGATE 1
#endif
#ifndef DUP_HP
#define DUP_HP 1
#endif
#ifndef DUP_PA
#define DUP_PA 1
#endif
#ifndef DUP_PB
#define DUP_PB 1
#endif
#ifndef DUP_PC
#define DUP_PC 1
#endif
#ifndef DUP_STG
#define DUP_STG 0
#endif
#ifndef DUP_ATTN
#define DUP_ATTN 1
#endif
#ifndef DUP_HS
#define DUP_HS 1
#endif
#ifndef DUP_SCAN
#define DUP_SCAN 1
#endif
#ifndef DUP_SYNC
#define DUP_SYNC 1
#endif

#define LAS __attribute__((address_space(3)))
typedef unsigned short bf16_t;
typedef short bf16x8 __attribute__((ext_vector_type(8)));
typedef float f32x4 __attribute__((ext_vector_type(4)));
typedef float f32x2 __attribute__((ext_vector_type(2)));
typedef unsigned u32x4 __attribute__((ext_vector_type(4)));
typedef unsigned u32x2 __attribute__((ext_vector_type(2)));

constexpr int RP = 16384;
constexpr int RS = 1024;
constexpr int R = RP + RS;
constexpr int DM = 1024;
constexpr int INC = 3328;
constexpr int NLAYER = 4;
constexpr float DN_ALPHA = 1.681792830507429f;
constexpr float NORM_EPS = 1e-5f;
constexpr int ZC_Q = 0, ZC_K = 512, ZC_V = 640, ZC_GA = 768, ZC_HQ = 1280, ZC_HF = 1792, ZC_HI = 2304, ZC_GH = 2816;
constexpr size_t O_Y = 0, O_KP = 17825792, O_VP = 18350080, O_SP = 18874368, O_KS = 20971520, O_VS = 29360128, O_SS = 37748736;
constexpr size_t WS_WIN = 0;
constexpr size_t WS_WOUT = WS_WIN + (size_t)4 * 3328 * 1024 * 2;
constexpr size_t WS_WPG = WS_WOUT + (size_t)4 * 1024 * 1024 * 2;
constexpr size_t WS_WPP = WS_WPG + (size_t)4 * 1024 * 1024 * 2;
constexpr size_t WS_C1 = WS_WPP + (size_t)4 * 1024 * 256 * 2;
constexpr size_t WS_C2 = WS_C1 + 16384;
constexpr size_t WS_LB = WS_C2 + 16384;
constexpr size_t WS_COS = WS_LB + 8192;
constexpr size_t WS_SIN = WS_COS + 263168;
constexpr size_t WS_XB = WS_SIN + 263168;
constexpr size_t WS_Z = WS_XB + (size_t)R * 1024 * 2;
constexpr size_t WS_MIX = WS_Z + (size_t)R * 3328 * 2;
constexpr size_t WS_PRE = WS_MIX + (size_t)R * 1024 * 2;
constexpr size_t WS_PREB = WS_PRE + (size_t)R * 1024 * 4;
constexpr size_t WS_STAT = WS_PREB + (size_t)R * 1024 * 2;
constexpr size_t WS_PB = WS_STAT + (size_t)R * 16 * 8;
constexpr size_t WS_PLE = WS_PB + (size_t)4 * R * 256 * 2;
constexpr size_t WS_BAR = WS_PLE + (size_t)R * 1024 * 2;
constexpr size_t WS_CP = WS_BAR + 16384;
constexpr size_t WS_END = WS_CP + 524288;
constexpr size_t WS_U = WS_PRE;
constexpr size_t WS_ST = WS_PREB;
constexpr size_t WS_DV = WS_PRE + 67108864;
static_assert(WS_DV + 1048576 <= WS_PREB, "DV fits in the PRE tail");
static_assert(WS_END <= (size_t)536870912, "workspace");
constexpr int LDS_BYTES = 135168;

struct Params {
    const float* x_prompt; const float* x_sample; const float* cache_k; const float* cache_v; const float* state;
    const float* p_prompt; const float* p_sample; const float* w_in; const float* sinks; const float* attn_g;
    const float* lb_logits; const float* hg_g; const float* w_out; const float* ln_g; const float* ln_b;
    const float* w_pp; const float* w_pg;
    float* out; unsigned char* ws;
};

__device__ __forceinline__ unsigned pk2(float lo, float hi) { unsigned r; asm volatile("v_cvt_pk_bf16_f32 %0, %1, %2" : "=v"(r) : "v"(lo), "v"(hi)); return r; }
__device__ __forceinline__ float bf2f(unsigned short b) { return __uint_as_float(((unsigned)b) << 16); }
__device__ __forceinline__ float bflo(unsigned w) { return __uint_as_float(w << 16); }
__device__ __forceinline__ float bfhi(unsigned w) { return __uint_as_float(w & 0xffff0000u); }
__device__ __forceinline__ float sigmoidf_(float x) { return __builtin_amdgcn_rcpf(1.0f + __expf(-x)); }

namespace pg8 {
constexpr int BM = 256, BK = 64, HALF = 128, HTB = HALF * BK * 2, STAGE_BYTES = 8 * HTB, NXCD = 8, WGM = 8;
__host__ __device__ __forceinline__ int lds_byte(int r, int c) { const int st = (r >> 4) * 2 + (c >> 5), rr = r & 15, cc = c & 31, ob = rr * 64 + cc * 2; return st * 1024 + (ob ^ (((ob >> 9) & 1) << 5)); }
__host__ __device__ __forceinline__ void stage_rc(int b, int& Rr, int& C) { const int st = b / 1024, sb = b % 1024, swz = sb ^ (((sb >> 9) & 1) << 5); Rr = (st >> 1) * 16 + swz / 64; C = (st & 1) * 32 + (swz % 64) / 2; }
__host__ __device__ __forceinline__ int perm32(int rho) { const int n = rho >> 4, i = rho & 15; return 8 * (i >> 2) + 4 * n + (i & 3); }
struct Unit { int pm, pn; };
struct Gemm { const bf16_t* A; const bf16_t* Bt; int M, N, K; };
struct StaticOrder {
    int nM, nN, nwg, G, c;
    __host__ __device__ void init(int M, int N, int G_, int c_) { nM = M / BM; nN = N / BM; nwg = nM * nN; G = G_; c = c_; }
    __host__ __device__ bool next(int i, Unit& u) const {
        const long L = (long)i * G + c; if (L >= nwg) return false;
        int wgid = (int)L; { const int q = nwg / NXCD, r = nwg % NXCD, xcd = wgid % NXCD, off = wgid / NXCD; wgid = (xcd < r ? xcd * (q + 1) : r * (q + 1) + (xcd - r) * q) + off; }
        const int nig = WGM * nN, gid = wgid / nig, fm = gid * WGM, gsz = (nM - fm) < WGM ? (nM - fm) : WGM;
        u.pm = fm + ((wgid % nig) % gsz); u.pn = (wgid % nig) / gsz; return true;
    }
};

template <class Epi, class Sched>
__device__ __forceinline__ void gemm_phase(LAS unsigned char* lds, const Gemm g, const Sched& S, const Epi& E) {
    int tid = threadIdx.x; asm volatile("" : "+v"(tid));
    const int wid = __builtin_amdgcn_readfirstlane(tid >> 6), lane = tid & 63, wr = wid >> 2, wc = wid & 3, fr = lane & 15, fq = lane >> 4;
    const int K = g.K, nt = K / BK;
    unsigned voffA[2], voffB[2];
#pragma unroll
    for (int i = 0; i < 2; ++i) { int Rr, C; stage_rc(tid * 16 + i * 8192, Rr, C); const int Rb = Epi::PERM ? ((Rr & ~31) + perm32(Rr & 31)) : Rr;
        voffA[i] = (unsigned)(Rr * K + C) * 2u; voffB[i] = (unsigned)(Rb * K + C) * 2u; }
    const size_t kstep = (size_t)(BK * 2);
    const size_t hstep = (size_t)HALF * K * 2;
    const size_t tstep = 2 * hstep;
    const unsigned ldsw = (unsigned)wid * 1024u;
    const int aoff = lds_byte(wr * 64 + fr, fq * 8), boff = lds_byte(wc * 32 + fr, fq * 8);
#define PG8_SA(b, h) (((b) * 2 + (h)) * HTB)
#define PG8_SB(b, h) ((4 + (b) * 2 + (h)) * HTB)
#define PG8_STAGE(bufoff, gbase, voff) do { _Pragma("unroll") for (int _i = 0; _i < 2; ++_i) \
        __builtin_amdgcn_global_load_lds((const unsigned*)((const char*)(gbase) + (voff)[_i]), (LAS unsigned*)(lds + (bufoff) + ldsw + _i * 8192), 16, 0, 0); } while (0)
#define PG8_LDA(dst, b, h) do { _Pragma("unroll") for (int m = 0; m < 4; ++m) _Pragma("unroll") for (int k = 0; k < 2; ++k) dst[m][k] = *(const LAS bf16x8*)(lds + PG8_SA(b, h) + aoff + m * 2048 + k * 1024); } while (0)
#define PG8_LDB(dst, b, h) do { _Pragma("unroll") for (int n = 0; n < 2; ++n) _Pragma("unroll") for (int k = 0; k < 2; ++k) dst[n][k] = *(const LAS bf16x8*)(lds + PG8_SB(b, h) + boff + n * 2048 + k * 1024); } while (0)
#define PG8_MMA(ai, bj, At, Bt) do { __builtin_amdgcn_s_setprio(1); _Pragma("unroll") for (int m = 0; m < 4; ++m) _Pragma("unroll") for (int n = 0; n < 2; ++n) _Pragma("unroll") for (int k = 0; k < 2; ++k) \
        acc[ai][bj][m][n] = __builtin_amdgcn_mfma_f32_16x16x32_bf16(Bt[n][k], At[m][k], acc[ai][bj][m][n], 0, 0, 0); __builtin_amdgcn_s_setprio(0); } while (0)
#define PG8_WAIT_V(n) asm volatile("s_waitcnt vmcnt(" #n ")" ::: "memory")
#define PG8_WAIT_L(n) asm volatile("s_waitcnt lgkmcnt(" #n ")" ::: "memory")
#define PG8_BAR __builtin_amdgcn_s_barrier()
#define PG8_SCHED __builtin_amdgcn_sched_barrier(0)
    Unit cur, nxt; int ui = 0;
    if (!S.next(0, cur)) return;
    f32x4 acc[2][2][4][2];
#pragma unroll
    for (int a = 0; a < 2; ++a)
#pragma unroll
        for (int b = 0; b < 2; ++b)
#pragma unroll
            for (int m = 0; m < 4; ++m)
#pragma unroll
                for (int n = 0; n < 2; ++n) acc[a][b][m][n] = (f32x4){0.f, 0.f, 0.f, 0.f};
    bf16x8 At[4][2], B0[2][2], B1[2][2];
    const char* cA = (const char*)g.A + (size_t)cur.pm * tstep; const char* cB = (const char*)g.Bt + (size_t)cur.pn * tstep;
    PG8_STAGE(PG8_SB(0, 0), cB, voffB); PG8_STAGE(PG8_SB(0, 1), cB + hstep, voffB); PG8_STAGE(PG8_SA(0, 0), cA, voffA); PG8_STAGE(PG8_SA(0, 1), cA + hstep, voffA);
    if (wr == 1) PG8_BAR;
    PG8_WAIT_V(2); PG8_BAR;
    PG8_STAGE(PG8_SB(1, 0), cB + kstep, voffB); PG8_STAGE(PG8_SA(1, 0), cA + kstep, voffA); PG8_STAGE(PG8_SB(1, 1), cB + hstep + kstep, voffB);
    PG8_WAIT_V(6); PG8_BAR;
    for (;;) {
        const bool has_next = S.next(ui + 1, nxt);
        const char* nA = has_next ? (const char*)g.A + (size_t)nxt.pm * tstep : cA; const char* nB = has_next ? (const char*)g.Bt + (size_t)nxt.pn * tstep : cB;
#pragma unroll 1
        for (int t = 0; t < nt; t += 2) {
            const bool last = (t == nt - 2);
            const char* a1 = cA + (size_t)(t + 1) * kstep;
            const char* a2 = last ? nA : cA + (size_t)(t + 2) * kstep; const char* b2 = last ? nB : cB + (size_t)(t + 2) * kstep;
            const char* a3 = a2 + kstep; const char* b3 = b2 + kstep;
            PG8_LDB(B0, 0, 0); PG8_LDB(B1, 0, 1); PG8_SCHED; PG8_LDA(At, 0, 0); PG8_STAGE(PG8_SA(1, 1), a1 + hstep, voffA);
            PG8_WAIT_V(8); PG8_WAIT_L(0); PG8_BAR; PG8_MMA(0, 0, At, B0); PG8_MMA(0, 1, At, B1); PG8_BAR; PG8_SCHED;
            PG8_LDA(At, 0, 1); PG8_STAGE(PG8_SB(0, 0), b2, voffB); PG8_STAGE(PG8_SB(0, 1), b2 + hstep, voffB); PG8_STAGE(PG8_SA(0, 0), a2, voffA);
            PG8_WAIT_V(8); PG8_WAIT_L(0); PG8_BAR; PG8_MMA(1, 0, At, B0); PG8_MMA(1, 1, At, B1); PG8_BAR; PG8_SCHED;
            PG8_LDB(B0, 1, 0); PG8_LDB(B1, 1, 1); PG8_SCHED; PG8_LDA(At, 1, 0); PG8_STAGE(PG8_SA(0, 1), a2 + hstep, voffA);
            PG8_WAIT_V(8); PG8_WAIT_L(0); PG8_BAR; PG8_MMA(0, 0, At, B0); PG8_MMA(0, 1, At, B1); PG8_BAR; PG8_SCHED;
            PG8_LDA(At, 1, 1); PG8_STAGE(PG8_SB(1, 0), b3, voffB); PG8_STAGE(PG8_SB(1, 1), b3 + hstep, voffB); PG8_STAGE(PG8_SA(1, 0), a3, voffA);
            PG8_WAIT_V(8); PG8_WAIT_L(0); PG8_BAR; PG8_MMA(1, 0, At, B0); PG8_MMA(1, 1, At, B1); PG8_BAR; PG8_SCHED;
        }
        if (wr == 0) PG8_BAR;
        E(acc, cur, wr, wc, fr, fq);
        if (!has_next) break;
#pragma unroll
        for (int a = 0; a < 2; ++a)
#pragma unroll
            for (int b = 0; b < 2; ++b)
#pragma unroll
                for (int m = 0; m < 4; ++m)
#pragma unroll
                    for (int n = 0; n < 2; ++n) acc[a][b][m][n] = (f32x4){0.f, 0.f, 0.f, 0.f};
        cur = nxt; cA = nA; cB = nB; ++ui;
        if (wr == 1) PG8_BAR;
    }
    PG8_WAIT_V(0);
    PG8_BAR;
#undef PG8_SA
#undef PG8_SB
#undef PG8_STAGE
#undef PG8_LDA
#undef PG8_LDB
#undef PG8_MMA
#undef PG8_WAIT_V
#undef PG8_WAIT_L
#undef PG8_BAR
#undef PG8_SCHED
}
}

struct EpiIn {
    static constexpr bool PERM = true;
    bf16_t* Z; const float* cosT; const float* sinT; const float* lb;
    float* kout_p; float* vout_p; float* kout_s; float* vout_s;
    template <int MODE>
    __device__ __forceinline__ void run(const f32x4 (&acc)[2][2][4][2], const pg8::Unit& u, int wr, int wc, int fr, int fq) const {
        const int pn = u.pn;
        constexpr bool ROPE_ANY = (MODE == 0 || MODE == 1);
        const int i0 = (wc & 1) * 16 + 4 * fq;
        f32x4 lbv[2][2];
        if (MODE == 4) {
#pragma unroll
            for (int bj = 0; bj < 2; ++bj) { const float* lp = lb + (pn - 7) * 256 + bj * 128 + wc * 32 + 8 * fq; lbv[bj][0] = *(const f32x4*)lp; lbv[bj][1] = *(const f32x4*)(lp + 4); }
        }
#pragma unroll
        for (int ai = 0; ai < 2; ++ai)
#pragma unroll
            for (int mp = 0; mp < 2; ++mp) {
                f32x4 csv[2], snv[2];
                if (ROPE_ANY) {
#pragma unroll
                    for (int k = 0; k < 2; ++k) {
                        const int row = u.pm * 256 + ai * 128 + wr * 64 + (2 * mp + k) * 16 + fr;
                        const int pidx = row < RP ? (row & 2047) : 2048 + ((row - RP) & 7);
                        csv[k] = *(const f32x4*)(cosT + pidx * 32 + i0); snv[k] = *(const f32x4*)(sinT + pidx * 32 + i0);
                    }
                }
#pragma unroll
                for (int k = 0; k < 2; ++k) {
                    const int m = 2 * mp + k;
                    const int row = u.pm * 256 + ai * 128 + wr * 64 + m * 16 + fr;
                    bf16_t* zrow = Z + (size_t)row * INC + pn * 256 + wc * 32 + 8 * fq;
                    float* kdst = nullptr; float* vdst = nullptr;
                    if (MODE == 1) {
                        const int kvh = wc >> 1;
                        if (row < RP) { const int t = row & 2047; if (t >= 1920) { const size_t o = ((size_t)((row >> 11) * 128 + (t - 1920)) * 2 + kvh) * 64; kdst = kout_p + o; vdst = vout_p + o; } }
                        else { const int rs = row - RP; const size_t o = ((size_t)((rs >> 3) * 128 + 120 + (rs & 7)) * 2 + kvh) * 64; kdst = kout_s + o; vdst = vout_s + o; }
                    }
#pragma unroll
                    for (int bj = 0; bj < 2; ++bj) {
                        f32x4 v0 = acc[ai][bj][m][0], v1 = acc[ai][bj][m][1];
                        const int co = bj * 128;
                        if (MODE == 0 || (MODE == 1 && bj == 0)) {
                            const f32x4 cs = csv[k], sn = snv[k];
                            f32x4 o0, o1;
                            o0.x = v0.x * cs.x - v0.y * sn.x; o0.y = v0.y * cs.x + v0.x * sn.x;
                            o0.z = v0.z * cs.y - v0.w * sn.y; o0.w = v0.w * cs.y + v0.z * sn.y;
                            o1.x = v1.x * cs.z - v1.y * sn.z; o1.y = v1.y * cs.z + v1.x * sn.z;
                            o1.z = v1.z * cs.w - v1.w * sn.w; o1.w = v1.w * cs.w + v1.z * sn.w;
                            if (MODE == 0) { o0 = o0 * 0.18033688011112042f; o1 = o1 * 0.18033688011112042f; }
                            else if (kdst) {
                                kdst[i0] = o0.x; kdst[i0 + 32] = o0.y; kdst[i0 + 1] = o0.z; kdst[i0 + 33] = o0.w;
                                kdst[i0 + 2] = o1.x; kdst[i0 + 34] = o1.y; kdst[i0 + 3] = o1.z; kdst[i0 + 35] = o1.w;
                            }
                            v0 = o0; v1 = o1;
                        } else if (MODE == 1) {
                            const int d0 = (wc & 1) * 32 + 8 * fq;
                            if (vdst) { *(f32x4*)(vdst + d0) = v0; *(f32x4*)(vdst + d0 + 4) = v1; }
                        } else if (MODE == 2) {
                            v0.x = v0.x * sigmoidf_(v0.x); v0.y = v0.y * sigmoidf_(v0.y); v0.z = v0.z * sigmoidf_(v0.z); v0.w = v0.w * sigmoidf_(v0.w);
                            v1.x = v1.x * sigmoidf_(v1.x); v1.y = v1.y * sigmoidf_(v1.y); v1.z = v1.z * sigmoidf_(v1.z); v1.w = v1.w * sigmoidf_(v1.w);
                        } else if (MODE == 4) {
                            const f32x4 l0 = lbv[bj][0], l1 = lbv[bj][1];
                            f32x4 o0, o1;
                            { const float sg = __builtin_amdgcn_rcpf(1.0f + __expf(-fmaxf(v0.x, -80.f))); o0.x = __logf(l0.x + (1.f - l0.x) * sg); }
                            { const float sg = __builtin_amdgcn_rcpf(1.0f + __expf(-fmaxf(v0.y, -80.f))); o0.y = __logf(l0.y + (1.f - l0.y) * sg); }
                            { const float sg = __builtin_amdgcn_rcpf(1.0f + __expf(-fmaxf(v0.z, -80.f))); o0.z = __logf(l0.z + (1.f - l0.z) * sg); }
                            { const float sg = __builtin_amdgcn_rcpf(1.0f + __expf(-fmaxf(v0.w, -80.f))); o0.w = __logf(l0.w + (1.f - l0.w) * sg); }
                            { const float sg = __builtin_amdgcn_rcpf(1.0f + __expf(-fmaxf(v1.x, -80.f))); o1.x = __logf(l1.x + (1.f - l1.x) * sg); }
                            { const float sg = __builtin_amdgcn_rcpf(1.0f + __expf(-fmaxf(v1.y, -80.f))); o1.y = __logf(l1.y + (1.f - l1.y) * sg); }
                            { const float sg = __builtin_amdgcn_rcpf(1.0f + __expf(-fmaxf(v1.z, -80.f))); o1.z = __logf(l1.z + (1.f - l1.z) * sg); }
                            { const float sg = __builtin_amdgcn_rcpf(1.0f + __expf(-fmaxf(v1.w, -80.f))); o1.w = __logf(l1.w + (1.f - l1.w) * sg); }
                            v0 = o0; v1 = o1;
                        }
                        u32x4 w; w.x = pk2(v0.x, v0.y); w.y = pk2(v0.z, v0.w); w.z = pk2(v1.x, v1.y); w.w = pk2(v1.z, v1.w);
                        *(u32x4*)(zrow + co) = w;
                    }
                }
                asm volatile("" ::: "memory");
            }
    }
    __device__ __forceinline__ void operator()(const f32x4 (&acc)[2][2][4][2], const pg8::Unit& u, int wr, int wc, int fr, int fq) const {
        const int pn = u.pn;
        if (pn < 2) run<0>(acc, u, wr, wc, fr, fq);
        else if (pn == 2) run<1>(acc, u, wr, wc, fr, fq);
        else if (pn == 3 || pn == 4 || pn >= 11) run<2>(acc, u, wr, wc, fr, fq);
        else if (pn == 7 || pn == 8) run<4>(acc, u, wr, wc, fr, fq);
        else run<3>(acc, u, wr, wc, fr, fq);
    }
};

struct EpiOut {
    static constexpr bool PERM = true;
    const float* xf_p; const float* xf_s;
    const bf16_t* xb;
    bf16_t* preb; f32x2* stat; int pm0;
    __device__ __forceinline__ void operator()(const f32x4 (&acc)[2][2][4][2], const pg8::Unit& u, int wr, int wc, int fr, int fq) const {
        const int c0 = u.pn * 256 + wc * 32 + 8 * fq;
#pragma unroll
        for (int ai = 0; ai < 2; ++ai) {
            u32x4 xw[4][2];
            if (!xf_p) {
#pragma unroll
                for (int m = 0; m < 4; ++m)
#pragma unroll
                    for (int bj = 0; bj < 2; ++bj)
                        xw[m][bj] = *(const u32x4*)(xb + (size_t)((u.pm + pm0) * 256 + ai * 128 + wr * 64 + m * 16 + fr) * DM + c0 + bj * 128);
            }
#pragma unroll
            for (int m = 0; m < 4; ++m) {
                const int row = (u.pm + pm0) * 256 + ai * 128 + wr * 64 + m * 16 + fr;
                bf16_t* pb = preb + (size_t)row * DM + c0;
                float s1 = 0.f, s2 = 0.f;
#pragma unroll
                for (int bj = 0; bj < 2; ++bj) {
                    const int co = bj * 128;
                    f32x4 x0, x1;
                    if (xf_p) { const float* xp = (row < RP ? xf_p + (size_t)row * DM : xf_s + (size_t)(row - RP) * DM) + c0 + co; x0 = *(const f32x4*)xp; x1 = *(const f32x4*)(xp + 4); }
                    else { const u32x4 w4 = xw[m][bj]; x0 = (f32x4){bflo(w4.x), bfhi(w4.x), bflo(w4.y), bfhi(w4.y)}; x1 = (f32x4){bflo(w4.z), bfhi(w4.z), bflo(w4.w), bfhi(w4.w)}; }
                    const f32x4 v0 = x0 * DN_ALPHA + acc[ai][bj][m][0], v1 = x1 * DN_ALPHA + acc[ai][bj][m][1];
                    s1 += ((v0.x + v0.y) + (v0.z + v0.w)) + ((v1.x + v1.y) + (v1.z + v1.w));
                    s2 += ((v0.x * v0.x + v0.y * v0.y) + (v0.z * v0.z + v0.w * v0.w)) + ((v1.x * v1.x + v1.y * v1.y) + (v1.z * v1.z + v1.w * v1.w));
                    u32x4 w; w.x = pk2(v0.x, v0.y); w.y = pk2(v0.z, v0.w); w.z = pk2(v1.x, v1.y); w.w = pk2(v1.z, v1.w);
                    *(u32x4*)(pb + co) = w;
                }
                s1 += __shfl_xor(s1, 16); s1 += __shfl_xor(s1, 32);
                s2 += __shfl_xor(s2, 16); s2 += __shfl_xor(s2, 32);
                if (fq == 0) stat[(size_t)row * 16 + u.pn * 4 + wc] = (f32x2){s1, s2};
            }
        }
    }
};

struct EpiPle {
    static constexpr bool PERM = true;
    bf16_t* ple;
    __device__ __forceinline__ void operator()(const f32x4 (&acc)[2][2][4][2], const pg8::Unit& u, int wr, int wc, int fr, int fq) const {
#pragma unroll
        for (int ai = 0; ai < 2; ++ai)
#pragma unroll
            for (int m = 0; m < 4; ++m) {
                const int row = u.pm * 256 + ai * 128 + wr * 64 + m * 16 + fr;
                bf16_t* pr = ple + (size_t)row * DM + u.pn * 256 + wc * 32 + 8 * fq;
#pragma unroll
                for (int bj = 0; bj < 2; ++bj) {
                    const f32x4 v0 = acc[ai][bj][m][0], v1 = acc[ai][bj][m][1];
                    u32x4 w; w.x = pk2(v0.x, v0.y); w.y = pk2(v0.z, v0.w); w.z = pk2(v1.x, v1.y); w.w = pk2(v1.z, v1.w);
                    *(u32x4*)(pr + bj * 128) = w;
                }
            }
    }
};

struct EpiGate {
    static constexpr bool PERM = true;
    const bf16_t* preb; const f32x2* stat; const bf16_t* ple; const float* c1; const float* c2; const float* lng; const float* lnb;
    float* yout; bf16_t* xb; LAS f32x2* srow; int pm0;
    __device__ __forceinline__ f32x4 four(const f32x4 a, const float pv0, const float pv1, const float pv2, const float pv3, const float pl0, const float pl1, const float pl2, const float pl3,
                                          const float mean, const float rs, const f32x4 c1v, const f32x4 c2v, const f32x4 gv, const f32x4 bv) const {
        f32x4 y;
        y.x = (pv0 - mean) * rs * gv.x + bv.x + sigmoidf_(rs * (a.x - mean * c1v.x) + c2v.x) * pl0;
        y.y = (pv1 - mean) * rs * gv.y + bv.y + sigmoidf_(rs * (a.y - mean * c1v.y) + c2v.y) * pl1;
        y.z = (pv2 - mean) * rs * gv.z + bv.z + sigmoidf_(rs * (a.z - mean * c1v.z) + c2v.z) * pl2;
        y.w = (pv3 - mean) * rs * gv.w + bv.w + sigmoidf_(rs * (a.w - mean * c1v.w) + c2v.w) * pl3;
        return y;
    }
    __device__ __forceinline__ void operator()(const f32x4 (&acc)[2][2][4][2], const pg8::Unit& u, int wr, int wc, int fr, int fq) const {
        {
            const int tid = threadIdx.x;
            if (tid < 256) {
                const f32x4* sp = (const f32x4*)(stat + (size_t)((u.pm + pm0) * 256 + tid) * 16);
                float s1 = 0.f, s2 = 0.f;
#pragma unroll
                for (int i = 0; i < 8; ++i) { const f32x4 t = sp[i]; s1 += t.x + t.z; s2 += t.y + t.w; }
                const float mean = s1 * (1.0f / DM);
                const float var = fmaxf(s2 * (1.0f / DM) - mean * mean, 0.f);
                srow[tid] = (f32x2){mean, rsqrtf(var + NORM_EPS)};
            }
            asm volatile("s_waitcnt lgkmcnt(0)" ::: "memory");
            __builtin_amdgcn_s_barrier();
            asm volatile("" ::: "memory");
        }
        float mu[2][4], rstd[2][4];
#pragma unroll
        for (int ai = 0; ai < 2; ++ai)
#pragma unroll
            for (int m = 0; m < 4; ++m) { const f32x2 t = srow[ai * 128 + wr * 64 + m * 16 + fr]; mu[ai][m] = t.x; rstd[ai][m] = t.y; }
#pragma unroll
        for (int bj = 0; bj < 2; ++bj) {
            const int c0 = u.pn * 256 + wc * 32 + 8 * fq + bj * 128;
            const f32x4 c1a = *(const f32x4*)(c1 + c0), c1b = *(const f32x4*)(c1 + c0 + 4), c2a = *(const f32x4*)(c2 + c0), c2b = *(const f32x4*)(c2 + c0 + 4);
            const f32x4 ga = *(const f32x4*)(lng + c0), gb = *(const f32x4*)(lng + c0 + 4), ba = *(const f32x4*)(lnb + c0), bb = *(const f32x4*)(lnb + c0 + 4);
#pragma unroll
            for (int am = 0; am < 4; ++am) {
                const int ai = am >> 1;
                u32x4 pvw[2], pw[2];
#pragma unroll
                for (int k = 0; k < 2; ++k) {
                    const int m = (am & 1) * 2 + k;
                    const size_t off = (size_t)((u.pm + pm0) * 256 + ai * 128 + wr * 64 + m * 16 + fr) * DM + c0;
                    pvw[k] = *(const u32x4*)(preb + off); pw[k] = *(const u32x4*)(ple + off);
                }
#pragma unroll
                for (int k = 0; k < 2; ++k) {
                    const int m = (am & 1) * 2 + k;
                    const size_t off = (size_t)((u.pm + pm0) * 256 + ai * 128 + wr * 64 + m * 16 + fr) * DM + c0;
                    const float mean = mu[ai][m], rs = rstd[ai][m];
                    const f32x4 y0 = four(acc[ai][bj][m][0], bflo(pvw[k].x), bfhi(pvw[k].x), bflo(pvw[k].y), bfhi(pvw[k].y), bflo(pw[k].x), bfhi(pw[k].x), bflo(pw[k].y), bfhi(pw[k].y), mean, rs, c1a, c2a, ga, ba);
                    const f32x4 y1 = four(acc[ai][bj][m][1], bflo(pvw[k].z), bfhi(pvw[k].z), bflo(pvw[k].w), bfhi(pvw[k].w), bflo(pw[k].z), bfhi(pw[k].z), bflo(pw[k].w), bfhi(pw[k].w), mean, rs, c1b, c2b, gb, bb);
                    if (yout) { __builtin_nontemporal_store(y0, (f32x4*)(yout + off)); __builtin_nontemporal_store(y1, (f32x4*)(yout + off + 4)); }
                    if (xb) { u32x4 w; w.x = pk2(y0.x, y0.y); w.y = pk2(y0.z, y0.w); w.z = pk2(y1.x, y1.y); w.w = pk2(y1.z, y1.w); *(u32x4*)(xb + off) = w; }
                }
                asm volatile("" ::: "memory");
            }
        }
    }
};

struct TItem { const float* W; bf16_t* WT; const float* gk; const float* bk; float* cp; int K, N, item, perm; };
__device__ __forceinline__ TItem p0_decode(const Params& P, int it) {
    constexpr int I_IN = 16 * 104, I_SQ = 16 * 32, I_PP = 4 * 32, I_L = I_IN + 2 * I_SQ + I_PP;
    const int l = it / I_L; int r = it % I_L;
    TItem t; t.gk = nullptr; t.bk = nullptr; t.cp = nullptr; t.perm = 0;
    if (r < I_IN) { t.W = P.w_in + (size_t)l * 1024 * INC; t.K = 1024; t.N = INC; t.WT = (bf16_t*)(P.ws + WS_WIN) + (size_t)l * INC * 1024; t.perm = 1; t.item = r; return t; }
    r -= I_IN;
    if (r < I_SQ) { t.W = P.w_out + (size_t)l * 1024 * 1024; t.K = 1024; t.N = 1024; t.WT = (bf16_t*)(P.ws + WS_WOUT) + (size_t)l * 1024 * 1024; t.item = r; return t; }
    r -= I_SQ;
    if (r < I_SQ) { t.W = P.w_pg + (size_t)l * 1024 * 1024; t.K = 1024; t.N = 1024; t.WT = (bf16_t*)(P.ws + WS_WPG) + (size_t)l * 1024 * 1024;
                    t.gk = P.ln_g + l * 1024; t.bk = P.ln_b + l * 1024; t.cp = (float*)(P.ws + WS_CP) + (size_t)l * 32768; t.item = r; return t; }
    r -= I_SQ;
    t.W = P.w_pp + (size_t)l * 256 * 1024; t.K = 256; t.N = 1024; t.WT = (bf16_t*)(P.ws + WS_WPP) + (size_t)l * 1024 * 256; t.item = r; return t;
}
__device__ __forceinline__ void p0_item_load(const TItem& t, f32x4 (&v)[8], int lane) {
    const int nblk = t.N / 32, kb = t.item / nblk, nb = t.item % nblk, k0 = 64 * kb, n0 = 32 * nb;
    const int r8 = lane >> 3, c4 = lane & 7;
#pragma unroll
    for (int i = 0; i < 8; ++i) v[i] = *(const f32x4*)(t.W + (size_t)(k0 + r8 + 8 * i) * t.N + n0 + c4 * 4);
}
__device__ __forceinline__ void p0_item_finish(const TItem& t, const f32x4 (&v)[8], LAS float* scr, int lane) {
    const int K = t.K, N = t.N;
    const int nblk = N / 32, kb = t.item / nblk, nb = t.item % nblk, k0 = 64 * kb, n0 = 32 * nb;
    const int r8 = lane >> 3, c4 = lane & 7;
#pragma unroll
    for (int i = 0; i < 8; ++i) { LAS float* p = scr + (r8 + 8 * i) * 33 + c4 * 4; p[0] = v[i].x; p[1] = v[i].y; p[2] = v[i].z; p[3] = v[i].w; }
    asm volatile("s_waitcnt lgkmcnt(0)" ::: "memory");
    if (t.cp) {
        const int n = lane & 31, half = lane >> 5;
        float s1 = 0.f, s2 = 0.f;
#pragma unroll 8
        for (int kk = half * 32; kk < half * 32 + 32; ++kk) { const float w = scr[kk * 33 + n]; s1 += t.gk[k0 + kk] * w; s2 += t.bk[k0 + kk] * w; }
        s1 += __shfl_xor(s1, 32); s2 += __shfl_xor(s2, 32);
        if (lane < 32) { t.cp[(size_t)kb * 2048 + n0 + n] = s1; t.cp[(size_t)kb * 2048 + 1024 + n0 + n] = s2; }
    }
    const int c = lane & 7;
    f32x4 g0 = (f32x4){1.f, 1.f, 1.f, 1.f}, g1 = g0;
    if (t.gk) { g0 = *(const f32x4*)(t.gk + k0 + 8 * c); g1 = *(const f32x4*)(t.gk + k0 + 8 * c + 4); }
#pragma unroll
    for (int j = 0; j < 4; ++j) {
        const int n = (lane >> 3) + 8 * j; const LAS float* sp = scr + (8 * c) * 33 + n;
        u32x4 o; o.x = pk2(sp[0 * 33] * g0.x, sp[1 * 33] * g0.y); o.y = pk2(sp[2 * 33] * g0.z, sp[3 * 33] * g0.w); o.z = pk2(sp[4 * 33] * g1.x, sp[5 * 33] * g1.y); o.w = pk2(sp[6 * 33] * g1.z, sp[7 * 33] * g1.w);
        int nd = n0 + n;
        if (t.perm && nd < 640) { const int dd = nd & 63; nd = (nd & ~63) + (dd < 32 ? 2 * dd : 2 * (dd - 32) + 1); }
        *(u32x4*)(t.WT + (size_t)nd * K + k0 + 8 * c) = o;
    }
    asm volatile("s_waitcnt lgkmcnt(0)" ::: "memory");
}

__device__ __forceinline__ void prologue(const Params& P, LAS unsigned char* lds) {
    int tid = threadIdx.x; asm volatile("" : "+v"(tid));
    const int wave = tid >> 6, lane = tid & 63;
    const int G = gridDim.x;
    const int gw = blockIdx.x * 8 + wave, NGW = G * 8;
    LAS float* scr = (LAS float*)(lds + wave * 8448);
    {
        constexpr int I_L = 16 * 104 + 2 * 16 * 32 + 4 * 32, TOTAL = NLAYER * I_L;
        if (gw < TOTAL) {
            TItem cur = p0_decode(P, gw); f32x4 v[8];
            p0_item_load(cur, v, lane);
#pragma unroll 1
            for (int it = gw; it < TOTAL; it += NGW) {
                const bool has = it + NGW < TOTAL;
                TItem nxt = cur; f32x4 w[8];
                if (has) { nxt = p0_decode(P, it + NGW); p0_item_load(nxt, w, lane); }
                p0_item_finish(cur, v, scr, lane);
                if (has) { cur = nxt;
#pragma unroll
                    for (int i = 0; i < 8; ++i) v[i] = w[i]; }
            }
        }
    }
    const size_t gt = (size_t)blockIdx.x * 512 + tid, GT = (size_t)G * 512;
    for (size_t ch0 = gt; ch0 < (size_t)R * 128; ch0 += 4 * GT) {
        f32x4 a[4], b[4];
#pragma unroll
        for (int k = 0; k < 4; ++k) {
            const size_t ch = ch0 + (size_t)k * GT;
            if (ch < (size_t)R * 128) {
                const size_t row = ch >> 7; const int c8 = (int)(ch & 127) * 8;
                const float* src = (row < RP ? P.x_prompt + row * DM : P.x_sample + (row - RP) * DM) + c8;
                a[k] = *(const f32x4*)src; b[k] = *(const f32x4*)(src + 4);
            }
        }
#pragma unroll
        for (int k = 0; k < 4; ++k) {
            const size_t ch = ch0 + (size_t)k * GT;
            if (ch < (size_t)R * 128) {
                const size_t row = ch >> 7; const int c8 = (int)(ch & 127) * 8;
                u32x4 o; o.x = pk2(a[k].x, a[k].y); o.y = pk2(a[k].z, a[k].w); o.z = pk2(b[k].x, b[k].y); o.w = pk2(b[k].z, b[k].w);
                *(u32x4*)((bf16_t*)(P.ws + WS_XB) + row * DM + c8) = o;
            }
        }
    }
    for (size_t ch0 = gt; ch0 < (size_t)NLAYER * R * 32; ch0 += 4 * GT) {
        f32x4 a[4], b[4];
#pragma unroll
        for (int k = 0; k < 4; ++k) {
            const size_t ch = ch0 + (size_t)k * GT;
            if (ch < (size_t)NLAYER * R * 32) {
                const size_t lr = ch >> 5; const int c8 = (int)(ch & 31) * 8;
                const size_t l = lr / R, row = lr % R;
                const float* src = (row < RP ? P.p_prompt + (l * RP + row) * 256 : P.p_sample + (l * RS + (row - RP)) * 256) + c8;
                a[k] = *(const f32x4*)src; b[k] = *(const f32x4*)(src + 4);
            }
        }
#pragma unroll
        for (int k = 0; k < 4; ++k) {
            const size_t ch = ch0 + (size_t)k * GT;
            if (ch < (size_t)NLAYER * R * 32) {
                const size_t lr = ch >> 5; const int c8 = (int)(ch & 31) * 8;
                u32x4 o; o.x = pk2(a[k].x, a[k].y); o.y = pk2(a[k].z, a[k].w); o.z = pk2(b[k].x, b[k].y); o.w = pk2(b[k].z, b[k].w);
                *(u32x4*)((bf16_t*)(P.ws + WS_PB) + lr * 256 + c8) = o;
            }
        }
    }
    for (size_t e = gt; e < (size_t)2056 * 32; e += GT) {
        const int pi = (int)(e >> 5), i = (int)(e & 31);
        const int pos = pi < 2048 ? pi : 8192 + (pi - 2048);
        const float inv = expf(-9.210340371976184f * (float)i * 2.0f / 64.0f);
        const float angf = (float)pos * inv;
        const double a = (double)angf;
        const double q = rint(a * 0.63661977236758134308);
        const double r = a - q * 1.57079632679489661923;
        const double r2 = r * r;
        const double sn = r * (1.0 + r2 * (-1.0 / 6 + r2 * (1.0 / 120 + r2 * (-1.0 / 5040 + r2 * (1.0 / 362880 + r2 * (-1.0 / 39916800 + r2 * (1.0 / 6227020800.0)))))));
        const double cs = 1.0 + r2 * (-0.5 + r2 * (1.0 / 24 + r2 * (-1.0 / 720 + r2 * (1.0 / 40320 + r2 * (-1.0 / 3628800 + r2 * (1.0 / 479001600.0))))));
        const int qi = ((int)q) & 3;
        const double c = qi == 0 ? cs : (qi == 1 ? -sn : (qi == 2 ? -cs : sn));
        const double s = qi == 0 ? sn : (qi == 1 ? cs : (qi == 2 ? -sn : -cs));
        ((float*)(P.ws + WS_COS))[e] = (float)c; ((float*)(P.ws + WS_SIN))[e] = (float)s;
    }
    if (blockIdx.x == 0) {
        const int d = tid;
        const float a0 = P.lb_logits[d], a1 = P.lb_logits[512 + d], a2 = P.lb_logits[1024 + d], a3 = P.lb_logits[1536 + d];
        const float mx = fmaxf(fmaxf(a0, a1), fmaxf(a2, a3));
        const float e0 = expf(a0 - mx), e1 = expf(a1 - mx), e2 = expf(a2 - mx), e3 = expf(a3 - mx);
        const float inv = 1.0f / (e0 + e1 + e2 + e3);
        float* lb = (float*)(P.ws + WS_LB);
        lb[d] = 0.f; lb[512 + d] = e1 * inv; lb[1024 + d] = (e1 + e2) * inv; lb[1536 + d] = (e1 + e2 + e3) * inv;
    }
}

#define MFMA16(a, b, c) __builtin_amdgcn_mfma_f32_16x16x32_bf16((a), (b), (c), 0, 0, 0)
__device__ __forceinline__ bf16x8 pack8(const f32x4 a, const f32x4 b) {
    u32x4 w; w.x = pk2(a.x, a.y); w.y = pk2(a.z, a.w); w.z = pk2(b.x, b.y); w.w = pk2(b.z, b.w);
    return __builtin_bit_cast(bf16x8, w);
}

template <int NQT, int NHALF, bool SAMPLE>
__device__ __forceinline__ void attn_unit(const Params& P, LAS unsigned char* lds, int layer, int unit) {
    int tid = threadIdx.x; asm volatile("" : "+v"(tid));
    const int wave = tid >> 6, lane = tid & 63, fr = lane & 15, g = lane >> 4;
    bf16_t* Z = (bf16_t*)(P.ws + WS_Z);
    LAS bf16_t* Ks = (LAS bf16_t*)lds;
    LAS bf16_t* VTs = (LAS bf16_t*)(lds + 55296);
    LAS float* red = (LAS float*)(lds + 106496);
    int row0, smin, smax;
    if (SAMPLE) { row0 = RP + unit * 8; smin = 0; smax = 136; }
    else { const int b = unit >> 5, qb = unit & 31; row0 = b * 2048 + qb * 64; smin = 128 - qb * 64; if (smin < 0) smin = 0; smax = 192; }
    __syncthreads();
    for (int ch = tid; ch < 3072; ch += 512) {
        const int c8 = ch & 7, s = (ch >> 3) % 192, kvh = ch / 1536;
        u32x4 kv = (u32x4){0u, 0u, 0u, 0u}, vv = (u32x4){0u, 0u, 0u, 0u};
        LAS bf16_t* kdst = Ks + (kvh * 192 + s) * 72;
        bool kdone = false;
        if (!SAMPLE) {
            if (s >= smin) { const size_t zr = (size_t)(row0 - 128 + s) * INC; kv = *(const u32x4*)(Z + zr + ZC_K + kvh * 64 + c8 * 8); vv = *(const u32x4*)(Z + zr + ZC_V + kvh * 64 + c8 * 8); }
        } else {
            if (s < 128) {
                const size_t co = ((((size_t)layer * 128 + unit) * 128 + s) * 2 + kvh) * 64 + c8 * 8;
                const f32x4 k0 = __builtin_nontemporal_load((const f32x4*)(P.cache_k + co)), k1 = __builtin_nontemporal_load((const f32x4*)(P.cache_k + co + 4));
                const f32x4 v0 = __builtin_nontemporal_load((const f32x4*)(P.cache_v + co)), v1 = __builtin_nontemporal_load((const f32x4*)(P.cache_v + co + 4));
                if (s >= 8) {
                    const size_t oo = ((((size_t)layer * 128 + unit) * 128 + (s - 8)) * 2 + kvh) * 64 + c8 * 8;
                    __builtin_nontemporal_store(k0, (f32x4*)(P.out + O_KS + oo)); __builtin_nontemporal_store(k1, (f32x4*)(P.out + O_KS + oo + 4));
                    __builtin_nontemporal_store(v0, (f32x4*)(P.out + O_VS + oo)); __builtin_nontemporal_store(v1, (f32x4*)(P.out + O_VS + oo + 4));
                }
                const int pb = (c8 < 4) ? (c8 * 16) : ((c8 - 4) * 16 + 1);
                kdst[pb + 0] = (bf16_t)(pk2(k0.x, 0.f) & 0xffffu); kdst[pb + 2] = (bf16_t)(pk2(k0.y, 0.f) & 0xffffu);
                kdst[pb + 4] = (bf16_t)(pk2(k0.z, 0.f) & 0xffffu); kdst[pb + 6] = (bf16_t)(pk2(k0.w, 0.f) & 0xffffu);
                kdst[pb + 8] = (bf16_t)(pk2(k1.x, 0.f) & 0xffffu); kdst[pb + 10] = (bf16_t)(pk2(k1.y, 0.f) & 0xffffu);
                kdst[pb + 12] = (bf16_t)(pk2(k1.z, 0.f) & 0xffffu); kdst[pb + 14] = (bf16_t)(pk2(k1.w, 0.f) & 0xffffu);
                kdone = true;
                vv.x = pk2(v0.x, v0.y); vv.y = pk2(v0.z, v0.w); vv.z = pk2(v1.x, v1.y); vv.w = pk2(v1.z, v1.w);
            } else if (s < 136) {
                const size_t zr = (size_t)(row0 + s - 128) * INC; kv = *(const u32x4*)(Z + zr + ZC_K + kvh * 64 + c8 * 8); vv = *(const u32x4*)(Z + zr + ZC_V + kvh * 64 + c8 * 8);
            }
        }
        if (!kdone) *(LAS u32x4*)(kdst + c8 * 8) = kv;
        LAS bf16_t* vdst = VTs + (kvh * 64 + c8 * 8) * 200 + s;
        vdst[0 * 200] = (bf16_t)(vv.x & 0xffffu); vdst[1 * 200] = (bf16_t)(vv.x >> 16);
        vdst[2 * 200] = (bf16_t)(vv.y & 0xffffu); vdst[3 * 200] = (bf16_t)(vv.y >> 16);
        vdst[4 * 200] = (bf16_t)(vv.z & 0xffffu); vdst[5 * 200] = (bf16_t)(vv.z >> 16);
        vdst[6 * 200] = (bf16_t)(vv.w & 0xffffu); vdst[7 * 200] = (bf16_t)(vv.w >> 16);
    }
    const int kvh = wave >> 2;
    const float sink = P.sinks[layer * 8 + wave] * 1.4426950408889634f;
    bf16_t* MIX = (bf16_t*)(P.ws + WS_MIX);
#pragma unroll 1
    for (int qh = 0; qh < NHALF; ++qh) {
    bf16x8 qf[NQT][2];
#pragma unroll
    for (int nt = 0; nt < NQT; ++nt)
#pragma unroll
        for (int ks = 0; ks < 2; ++ks) {
            int q = (qh * NQT + nt) * 16 + fr; if (SAMPLE && q > 7) q = 7;
            qf[nt][ks] = *(const bf16x8*)(Z + (size_t)(row0 + q) * INC + ZC_Q + wave * 64 + ks * 32 + g * 8);
        }
    f32x4 agv[4]; u32x4 asg[NQT][2];
#pragma unroll
    for (int pp = 0; pp < 2; ++pp) {
        const int c = wave * 64 + 32 * pp + 8 * g;
        agv[2 * pp] = *(const f32x4*)(P.attn_g + layer * 512 + c); agv[2 * pp + 1] = *(const f32x4*)(P.attn_g + layer * 512 + c + 4);
#pragma unroll
        for (int nt = 0; nt < NQT; ++nt) { int q = (qh * NQT + nt) * 16 + fr; if (SAMPLE && q > 7) q = 7; asg[nt][pp] = *(const u32x4*)(Z + (size_t)(row0 + q) * INC + ZC_GA + c); }
    }
    if (qh == 0) __syncthreads();

    float m_run[NQT], l_run[NQT];
    int dq[NQT];
    f32x4 ot[4][NQT];
#pragma unroll
    for (int nt = 0; nt < NQT; ++nt) { m_run[nt] = sink; l_run[nt] = 0.f; dq[nt] = (qh * NQT + nt) * 16 + fr - 8 * g;
#pragma unroll
        for (int dt = 0; dt < 4; ++dt) ot[dt][nt] = (f32x4){0.f, 0.f, 0.f, 0.f}; }
#pragma unroll
    for (int kb = 0; kb < 3; ++kb) {
        if (kb * 64 + 63 < smin) continue;
        f32x4 st[4][NQT];
#pragma unroll
        for (int kt = 0; kt < 4; ++kt) {
            const int key_r = kb * 64 + (kt >> 1) * 32 + 8 * (fr >> 2) + 4 * (kt & 1) + (fr & 3);
#pragma unroll
            for (int nt = 0; nt < NQT; ++nt) st[kt][nt] = (f32x4){0.f, 0.f, 0.f, 0.f};
#pragma unroll
            for (int ks = 0; ks < 2; ++ks) {
                const bf16x8 kf = *(const LAS bf16x8*)(Ks + (kvh * 192 + key_r) * 72 + ks * 32 + g * 8);
#pragma unroll
                for (int nt = 0; nt < NQT; ++nt) st[kt][nt] = MFMA16(kf, qf[nt][ks], st[kt][nt]);
            }
        }
#pragma unroll
        for (int nt = 0; nt < NQT; ++nt) {
            float mx = m_run[nt];
#pragma unroll
            for (int kt = 0; kt < 4; ++kt)
#pragma unroll
                for (int j = 0; j < 4; ++j) {
                    const int c = kb * 64 + (kt >> 1) * 32 + 4 * (kt & 1) + j;
                    float v = st[kt][nt][j];
                    if (kb == 0) v = (c > dq[nt]) ? v : -1e30f;
                    if (kb == 2) v = (c - 128 <= dq[nt]) ? v : -1e30f;
                    if (SAMPLE && kb == 2) v = (c + 8 * g < smax) ? v : -1e30f;
                    st[kt][nt][j] = v; mx = fmaxf(mx, v);
                }
            mx = fmaxf(mx, __shfl_xor(mx, 16)); mx = fmaxf(mx, __shfl_xor(mx, 32));
            const float alpha = __builtin_amdgcn_exp2f(m_run[nt] - mx); m_run[nt] = mx;
            float psum = 0.f;
#pragma unroll
            for (int kt = 0; kt < 4; ++kt)
#pragma unroll
                for (int j = 0; j < 4; ++j) { const float p = __builtin_amdgcn_exp2f(st[kt][nt][j] - mx); st[kt][nt][j] = p; psum += p; }
            l_run[nt] = l_run[nt] * alpha + psum;
#pragma unroll
            for (int dt = 0; dt < 4; ++dt) ot[dt][nt] = ot[dt][nt] * alpha;
        }
#pragma unroll
        for (int kg = 0; kg < 2; ++kg) {
            bf16x8 pf[NQT];
#pragma unroll
            for (int nt = 0; nt < NQT; ++nt) pf[nt] = pack8(st[2 * kg][nt], st[2 * kg + 1][nt]);
#pragma unroll
            for (int dt = 0; dt < 4; ++dt) {
                const bf16x8 vf = *(const LAS bf16x8*)(VTs + (kvh * 64 + 32 * (dt >> 1) + 8 * (fr >> 2) + 4 * (dt & 1) + (fr & 3)) * 200 + kb * 64 + kg * 32 + 8 * g);
#pragma unroll
                for (int nt = 0; nt < NQT; ++nt) ot[dt][nt] = MFMA16(vf, pf[nt], ot[dt][nt]);
            }
        }
    }
#pragma unroll
    for (int nt = 0; nt < NQT; ++nt) {
        float ls = l_run[nt]; ls += __shfl_xor(ls, 16); ls += __shfl_xor(ls, 32);
        const float inv = 1.0f / (ls + __builtin_amdgcn_exp2f(sink - m_run[nt]));
        float ssq = 0.f;
#pragma unroll
        for (int dt = 0; dt < 4; ++dt) { ot[dt][nt] = ot[dt][nt] * inv; const f32x4 o = ot[dt][nt]; ssq += (o.x * o.x + o.y * o.y) + (o.z * o.z + o.w * o.w); }
        ssq += __shfl_xor(ssq, 16); ssq += __shfl_xor(ssq, 32);
        if (g == 0) red[qh * 512 + wave * 64 + nt * 16 + fr] = ssq;
    }
    __syncthreads();
#pragma unroll
    for (int nt = 0; nt < NQT; ++nt) {
        const int q = (qh * NQT + nt) * 16 + fr;
        float tot = 0.f;
#pragma unroll
        for (int w = 0; w < 8; ++w) tot += red[qh * 512 + w * 64 + nt * 16 + fr];
        const float rs = rsqrtf(tot * (1.0f / 512.0f) + NORM_EPS);
        if (!SAMPLE || q < 8) {
            const size_t row = (size_t)(row0 + q);
#pragma unroll
            for (int pp = 0; pp < 2; ++pp) {
                const int c = wave * 64 + 32 * pp + 8 * g;
                const f32x4 g0 = agv[2 * pp], g1 = agv[2 * pp + 1];
                const u32x4 sg = asg[nt][pp];
                const f32x4 o0 = ot[2 * pp][nt], o1 = ot[2 * pp + 1][nt];
                u32x4 w;
                w.x = pk2(o0.x * rs * g0.x * bflo(sg.x), o0.y * rs * g0.y * bfhi(sg.x)); w.y = pk2(o0.z * rs * g0.z * bflo(sg.y), o0.w * rs * g0.w * bfhi(sg.y));
                w.z = pk2(o1.x * rs * g1.x * bflo(sg.z), o1.y * rs * g1.y * bfhi(sg.z)); w.w = pk2(o1.z * rs * g1.z * bflo(sg.w), o1.w * rs * g1.w * bfhi(sg.w));
                *(u32x4*)(MIX + row * DM + c) = w;
            }
        }
    }
    }
}

template <bool SAMPLE>
__device__ __forceinline__ void hgrn_unit(const Params& P, LAS unsigned char* lds, int layer, int unit) {
    int tid = threadIdx.x; asm volatile("" : "+v"(tid));
    const int wave = tid >> 6, lane = tid & 63, fr = lane & 15, g = lane >> 4;
    const int b = unit >> 2, h = unit & 3;
    bf16_t* Z = (bf16_t*)(P.ws + WS_Z);
    bf16_t* MIX = (bf16_t*)(P.ws + WS_MIX);
    LAS bf16_t* Qs = (LAS bf16_t*)lds;
    LAS bf16_t* Ks = (LAS bf16_t*)(lds + 17408);
    LAS bf16_t* KTs = (LAS bf16_t*)(lds + 34816);
    LAS bf16_t* VTs = (LAS bf16_t*)(lds + 53248);
    LAS bf16_t* STs = (LAS bf16_t*)(lds + 71680);
    LAS float* part = (LAS float*)(lds + 106496);
    LAS float* red = (LAS float*)(lds + 108544);
    constexpr int nchunk = SAMPLE ? 1 : 32;
    constexpr int tvalid = SAMPLE ? 8 : 64;
    const size_t rowbase = SAMPLE ? (size_t)(RP + b * 8) : (size_t)b * 2048;
    const int d = tid & 127, tq = tid >> 7;
    const int nt = wave & 3, vh = wave >> 2;
    unsigned short r_lf[16], r_q[16], r_v[16];
#pragma unroll
    for (int i = 0; i < 16; ++i) {
        const int t = tq * 16 + i;
        r_lf[i] = 0; r_q[i] = 0; r_v[i] = 0;
        if (SAMPLE && t < tvalid) { const bf16_t* zr = Z + (rowbase + t) * INC + h * 128 + d; r_lf[i] = zr[ZC_HF]; r_q[i] = zr[ZC_HQ]; r_v[i] = zr[ZC_HI]; }
    }
    f32x4 hgv[4]; u32x4 hsg[2];
    if (SAMPLE) {
        int t = nt * 16 + fr; if (t > tvalid - 1) t = tvalid - 1;
#pragma unroll
        for (int pp = 0; pp < 2; ++pp) {
            const int v0 = h * 128 + vh * 64 + 32 * pp + 8 * g;
            hgv[2 * pp] = *(const f32x4*)(P.hg_g + layer * 512 + v0); hgv[2 * pp + 1] = *(const f32x4*)(P.hg_g + layer * 512 + v0 + 4);
            hsg[pp] = *(const u32x4*)(Z + (rowbase + t) * INC + ZC_GH + v0);
        }
    }
    f32x4 sacc[8];
    if (SAMPLE) {
        const float* S0 = P.state + (((size_t)layer * 128 + b) * 4 + h) * 16384;
#pragma unroll
        for (int j = 0; j < 4; ++j) {
            const float* sp = S0 + (size_t)(16 * wave + 4 * g + j) * 128 + 8 * fr;
            const f32x4 a0 = __builtin_nontemporal_load((const f32x4*)sp), a1 = __builtin_nontemporal_load((const f32x4*)(sp + 4));
            sacc[0][j] = a0.x; sacc[1][j] = a0.y; sacc[2][j] = a0.z; sacc[3][j] = a0.w; sacc[4][j] = a1.x; sacc[5][j] = a1.y; sacc[6][j] = a1.z; sacc[7][j] = a1.w;
        }
    } else {
#pragma unroll
        for (int vt = 0; vt < 8; ++vt) sacc[vt] = (f32x4){0.f, 0.f, 0.f, 0.f};
    }
    __syncthreads();
#pragma unroll 1
    for (int c = 0; c < nchunk; ++c) {
        const size_t row0 = rowbase + (size_t)c * 64;
        float lf[16], qv[16];
        float loc = 0.f;
#pragma unroll
        for (int i = 0; i < 16; ++i) {
            const int t = tq * 16 + i;
            bf16_t vraw = 0; lf[i] = 0.f; qv[i] = 0.f;
            if (SAMPLE) { lf[i] = bf2f(r_lf[i]); qv[i] = bf2f(r_q[i]); vraw = r_v[i]; }
            else if (t < tvalid) {
                const bf16_t* zr = Z + (row0 + t) * INC + h * 128 + d;
                lf[i] = bf2f(zr[ZC_HF]); qv[i] = bf2f(zr[ZC_HQ]); vraw = zr[ZC_HI];
            }
            loc += lf[i];
            VTs[d * 72 + t] = vraw;
        }
        part[tq * 128 + d] = loc;
        __syncthreads();
        {
            const float p0 = part[d], p1 = part[128 + d], p2 = part[256 + d];
            const float gref = p0 + p1;
            float G = (tq > 0 ? p0 : 0.f) + (tq > 1 ? p1 : 0.f) + (tq > 2 ? p2 : 0.f);
#pragma unroll
            for (int i = 0; i < 16; ++i) {
                const int t = tq * 16 + i;
                G += lf[i];
                const float kk = 1.0f - __expf(lf[i]);
                const float eq = __expf(G - gref), ek = __expf(gref - G);
                const bf16_t qb = (bf16_t)(pk2(qv[i] * eq, 0.f) & 0xffffu);
                const bf16_t kb = (bf16_t)(pk2(kk * ek, 0.f) & 0xffffu);
                Qs[t * 136 + d] = qb; Ks[t * 136 + d] = kb; KTs[d * 72 + t] = kb;
            }
            float eg[4];
#pragma unroll
            for (int j = 0; j < 4; ++j) { const int dj = 16 * wave + 4 * g + j; eg[j] = __expf(part[dj] + part[128 + dj]); }
#pragma unroll
            for (int vt = 0; vt < 8; ++vt) {
#pragma unroll
                for (int j = 0; j < 4; ++j) sacc[vt][j] *= eg[j];
                u32x2 w; w.x = pk2(sacc[vt].x, sacc[vt].y); w.y = pk2(sacc[vt].z, sacc[vt].w);
                *(LAS u32x2*)(STs + (8 * fr + vt) * 136 + 16 * wave + 4 * g) = w;
            }
        }
        __syncthreads();
        bf16x8 qf[4];
#pragma unroll
        for (int ks = 0; ks < 4; ++ks) qf[ks] = *(const LAS bf16x8*)(Qs + (nt * 16 + fr) * 136 + ks * 32 + g * 8);
        bf16x8 pf[2];
#pragma unroll
        for (int sg = 0; sg < 2; ++sg) {
            f32x4 at0 = (f32x4){0.f, 0.f, 0.f, 0.f}, at1 = (f32x4){0.f, 0.f, 0.f, 0.f};
            if (sg * 32 <= nt * 16 + 15) {
                const int sr0 = sg * 32 + 8 * (fr >> 2) + (fr & 3), sr1 = sr0 + 4;
#pragma unroll
                for (int ks = 0; ks < 4; ++ks) {
                    const bf16x8 k0 = *(const LAS bf16x8*)(Ks + sr0 * 136 + ks * 32 + g * 8);
                    const bf16x8 k1 = *(const LAS bf16x8*)(Ks + sr1 * 136 + ks * 32 + g * 8);
                    at0 = MFMA16(k0, qf[ks], at0); at1 = MFMA16(k1, qf[ks], at1);
                }
                const int t = nt * 16 + fr;
#pragma unroll
                for (int j = 0; j < 4; ++j) {
                    const int s0 = sg * 32 + 8 * g + j, s1 = s0 + 4;
                    if (s0 > t) at0[j] = 0.f;
                    if (s1 > t) at1[j] = 0.f;
                }
            }
            pf[sg] = pack8(at0, at1);
        }
        f32x4 ot[4];
#pragma unroll
        for (int vi = 0; vi < 4; ++vi) {
            const int vrow = vh * 64 + 32 * (vi >> 1) + 8 * (fr >> 2) + 4 * (vi & 1) + (fr & 3);
            f32x4 o = (f32x4){0.f, 0.f, 0.f, 0.f};
#pragma unroll
            for (int sg = 0; sg < 2; ++sg) {
                if (sg * 32 <= nt * 16 + 15) {
                    const bf16x8 vf = *(const LAS bf16x8*)(VTs + vrow * 72 + sg * 32 + 8 * g);
                    o = MFMA16(vf, pf[sg], o);
                }
            }
#pragma unroll
            for (int ks = 0; ks < 4; ++ks) {
                const bf16x8 sf = *(const LAS bf16x8*)(STs + vrow * 136 + ks * 32 + 8 * g);
                o = MFMA16(sf, qf[ks], o);
            }
            ot[vi] = o;
        }
#pragma unroll
        for (int ks = 0; ks < 2; ++ks) {
            const bf16x8 ktf = *(const LAS bf16x8*)(KTs + (16 * wave + fr) * 72 + ks * 32 + 8 * g);
#pragma unroll
            for (int vt = 0; vt < 8; ++vt) {
                const bf16x8 vf = *(const LAS bf16x8*)(VTs + (8 * fr + vt) * 72 + ks * 32 + 8 * g);
                sacc[vt] = MFMA16(ktf, vf, sacc[vt]);
            }
        }
        {
            float el[4];
#pragma unroll
            for (int j = 0; j < 4; ++j) { const int dj = 16 * wave + 4 * g + j; el[j] = __expf(part[256 + dj] + part[384 + dj]); }
#pragma unroll
            for (int vt = 0; vt < 8; ++vt)
#pragma unroll
                for (int j = 0; j < 4; ++j) sacc[vt][j] *= el[j];
        }
        float ssq = 0.f;
#pragma unroll
        for (int vi = 0; vi < 4; ++vi) { const f32x4 o = ot[vi]; ssq += (o.x * o.x + o.y * o.y) + (o.z * o.z + o.w * o.w); }
        ssq += __shfl_xor(ssq, 16); ssq += __shfl_xor(ssq, 32);
        if (g == 0) red[vh * 64 + nt * 16 + fr] = ssq;
        __syncthreads();
        {
            const int t = nt * 16 + fr;
            const float tot = red[t] + red[64 + t];
            const float rs = rsqrtf(tot * (1.0f / 128.0f) + NORM_EPS);
            if (t < tvalid) {
                const size_t row = row0 + t;
#pragma unroll
                for (int pp = 0; pp < 2; ++pp) {
                    const int v0 = h * 128 + vh * 64 + 32 * pp + 8 * g;
                    f32x4 g0, g1; u32x4 sg;
                    if (SAMPLE) { g0 = hgv[2 * pp]; g1 = hgv[2 * pp + 1]; sg = hsg[pp]; }
                    else { g0 = *(const f32x4*)(P.hg_g + layer * 512 + v0); g1 = *(const f32x4*)(P.hg_g + layer * 512 + v0 + 4); sg = *(const u32x4*)(Z + row * INC + ZC_GH + v0); }
                    const f32x4 o0 = ot[2 * pp], o1 = ot[2 * pp + 1];
                    u32x4 w;
                    w.x = pk2(o0.x * rs * g0.x * bflo(sg.x), o0.y * rs * g0.y * bfhi(sg.x)); w.y = pk2(o0.z * rs * g0.z * bflo(sg.y), o0.w * rs * g0.w * bfhi(sg.y));
                    w.z = pk2(o1.x * rs * g1.x * bflo(sg.z), o1.y * rs * g1.y * bfhi(sg.z)); w.w = pk2(o1.z * rs * g1.z * bflo(sg.w), o1.w * rs * g1.w * bfhi(sg.w));
                    *(u32x4*)(MIX + row * DM + 512 + v0) = w;
                }
            }
        }
    }
    float* So = SAMPLE ? P.out + O_SS + (((size_t)layer * 128 + b) * 4 + h) * 16384 : P.out + O_SP + (((size_t)layer * 8 + b) * 4 + h) * 16384;
#pragma unroll
    for (int j = 0; j < 4; ++j) {
        float* sp = So + (size_t)(16 * wave + 4 * g + j) * 128 + 8 * fr;
        __builtin_nontemporal_store((f32x4){sacc[0][j], sacc[1][j], sacc[2][j], sacc[3][j]}, (f32x4*)sp);
        __builtin_nontemporal_store((f32x4){sacc[4][j], sacc[5][j], sacc[6][j], sacc[7][j]}, (f32x4*)(sp + 4));
    }
}


template <int MODE>
__device__ __forceinline__ int hgrn_chunk_loop(const Params& P, LAS unsigned char* lds, int layer, int u0, int lo, int hi, unsigned* ctr, int qbase, LAS unsigned* slot) {
    int tid = threadIdx.x; asm volatile("" : "+v"(tid));
    const int wave = tid >> 6, lane = tid & 63, fr = lane & 15, g = lane >> 4;
    bf16_t* Z = (bf16_t*)(P.ws + WS_Z);
    bf16_t* MIX = (bf16_t*)(P.ws + WS_MIX);
    LAS bf16_t* Qs = (LAS bf16_t*)lds;
    LAS bf16_t* Ks = (LAS bf16_t*)(lds + 17408);
    LAS bf16_t* KTs = (LAS bf16_t*)(lds + 34816);
    LAS bf16_t* VTs = (LAS bf16_t*)(lds + 53248);
    LAS bf16_t* STs = (LAS bf16_t*)(lds + 71680);
    LAS float* part = (LAS float*)(lds + 106496);
    LAS float* red = (LAS float*)(lds + 108544);
    const int d = tid & 127, tq = tid >> 7;
    const int nt = wave & 3, vh = wave >> 2;
    unsigned short rlf[16], rq[16], rv[16];
#define HG_LOAD_RAW(unit_) do { const int _bh = (unit_) >> 5, _c = (unit_) & 31; \
        const bf16_t* _zr = Z + ((size_t)(_bh >> 2) * 2048 + (size_t)_c * 64 + tq * 16) * INC + (_bh & 3) * 128 + d; \
        _Pragma("unroll") for (int i = 0; i < 16; ++i) { rlf[i] = _zr[(size_t)i * INC + ZC_HF]; if (MODE == 1) rq[i] = _zr[(size_t)i * INC + ZC_HQ]; rv[i] = _zr[(size_t)i * INC + ZC_HI]; } } while (0)
    int unit = u0 - lo;
    HG_LOAD_RAW(unit);
    u32x4 stv[4];
#define HG_LOAD_ST(unit_) do { const bf16_t* _st = (const bf16_t*)(P.ws + WS_ST) + (size_t)(unit_) * 16384; \
        _Pragma("unroll") for (int k = 0; k < 4; ++k) { const int _i = tid + 512 * k; stv[k] = *(const u32x4*)(_st + (_i >> 4) * 128 + (_i & 15) * 8); } } while (0)
    if (MODE == 1) HG_LOAD_ST(unit);
#pragma unroll 1
    for (;;) {
        const int bh = unit >> 5, c = unit & 31, b = bh >> 2, h = bh & 3;
        const size_t row0 = (size_t)b * 2048 + (size_t)c * 64;
        u32x4 sgv[2]; f32x4 gvv[4];
        if (MODE == 1) {
#pragma unroll
            for (int pp = 0; pp < 2; ++pp) {
                const int v0 = h * 128 + vh * 64 + 32 * pp + 8 * g;
                gvv[2 * pp] = *(const f32x4*)(P.hg_g + layer * 512 + v0); gvv[2 * pp + 1] = *(const f32x4*)(P.hg_g + layer * 512 + v0 + 4);
                sgv[pp] = *(const u32x4*)(Z + (row0 + nt * 16 + fr) * INC + ZC_GH + v0);
            }
        }
        __syncthreads();
        unsigned popped = 0u;
        if (tid == 0) popped = __hip_atomic_fetch_add(ctr, 1u, __ATOMIC_RELAXED, __HIP_MEMORY_SCOPE_AGENT);
        float lf[16], qv[16];
        float loc = 0.f;
#pragma unroll
        for (int i = 0; i < 16; ++i) {
            const int t = tq * 16 + i;
            lf[i] = bf2f(rlf[i]); qv[i] = (MODE == 1) ? bf2f(rq[i]) : 0.f;
            loc += lf[i];
            VTs[d * 72 + t] = rv[i];
        }
        part[tq * 128 + d] = loc;
        if (tid == 0) slot[0] = (unsigned)qbase + popped;
        __syncthreads();
        const int nu = (int)slot[0];
        const bool more = (nu >= lo) && (nu < hi);
        {
            const float p0 = part[d], p1 = part[128 + d], p2 = part[256 + d];
            const float gref = p0 + p1;
            float G = (tq > 0 ? p0 : 0.f) + (tq > 1 ? p1 : 0.f) + (tq > 2 ? p2 : 0.f);
#pragma unroll
            for (int i = 0; i < 16; ++i) {
                const int t = tq * 16 + i;
                G += lf[i];
                const float kk = 1.0f - __expf(lf[i]);
                const float ek = __expf(gref - G);
                const bf16_t kb = (bf16_t)(pk2(kk * ek, 0.f) & 0xffffu);
                if (MODE == 0) KTs[d * 72 + t] = kb;
                else {
                    const float eq = __expf(G - gref);
                    Ks[t * 136 + d] = kb; Qs[t * 136 + d] = (bf16_t)(pk2(qv[i] * eq, 0.f) & 0xffffu);
                }
            }
            if (MODE == 1) {
#pragma unroll
                for (int k = 0; k < 4; ++k) { const int i = tid + 512 * k; *(LAS u32x4*)(STs + (i >> 4) * 136 + (i & 15) * 8) = stv[k]; }
            }
            if (MODE == 0 && tq == 0) {
                float* DV = (float*)(P.ws + WS_DV) + (size_t)unit * 256;
                DV[d] = __expf(gref + p2 + part[384 + d]); DV[128 + d] = __expf(gref);
            }
        }
        __syncthreads();
        if (more) { HG_LOAD_RAW(nu - lo); if (MODE == 1) HG_LOAD_ST(nu - lo); }
        if (MODE == 0) {
            f32x4 sacc[8];
#pragma unroll
            for (int vt = 0; vt < 8; ++vt) sacc[vt] = (f32x4){0.f, 0.f, 0.f, 0.f};
#pragma unroll
            for (int ks = 0; ks < 2; ++ks) {
                const bf16x8 ktf = *(const LAS bf16x8*)(KTs + (16 * wave + fr) * 72 + ks * 32 + 8 * g);
#pragma unroll
                for (int vt = 0; vt < 8; ++vt) {
                    const bf16x8 vf = *(const LAS bf16x8*)(VTs + (vt * 16 + fr) * 72 + ks * 32 + 8 * g);
                    sacc[vt] = MFMA16(ktf, vf, sacc[vt]);
                }
            }
            float el[4];
#pragma unroll
            for (int j = 0; j < 4; ++j) { const int dj = 16 * wave + 4 * g + j; el[j] = __expf(part[256 + dj] + part[384 + dj]); }
            bf16_t* UT = (bf16_t*)(P.ws + WS_U) + (size_t)unit * 16384;
#pragma unroll
            for (int vt = 0; vt < 8; ++vt) {
                f32x4 o; o.x = sacc[vt].x * el[0]; o.y = sacc[vt].y * el[1]; o.z = sacc[vt].z * el[2]; o.w = sacc[vt].w * el[3];
                u32x2 uw; uw.x = pk2(o.x, o.y); uw.y = pk2(o.z, o.w);
                *(u32x2*)(UT + (vt * 16 + fr) * 128 + 16 * wave + 4 * g) = uw;
            }
        } else {
            bf16x8 qf[4];
#pragma unroll
            for (int ks = 0; ks < 4; ++ks) qf[ks] = *(const LAS bf16x8*)(Qs + (nt * 16 + fr) * 136 + ks * 32 + g * 8);
            bf16x8 pf[2];
#pragma unroll
            for (int sg = 0; sg < 2; ++sg) {
                f32x4 at0 = (f32x4){0.f, 0.f, 0.f, 0.f}, at1 = (f32x4){0.f, 0.f, 0.f, 0.f};
                if (sg * 32 <= nt * 16 + 15) {
                    const int sr0 = sg * 32 + 8 * (fr >> 2) + (fr & 3), sr1 = sr0 + 4;
#pragma unroll
                    for (int ks = 0; ks < 4; ++ks) {
                        const bf16x8 k0 = *(const LAS bf16x8*)(Ks + sr0 * 136 + ks * 32 + g * 8);
                        const bf16x8 k1 = *(const LAS bf16x8*)(Ks + sr1 * 136 + ks * 32 + g * 8);
                        at0 = MFMA16(k0, qf[ks], at0); at1 = MFMA16(k1, qf[ks], at1);
                    }
                    const int t = nt * 16 + fr;
#pragma unroll
                    for (int j = 0; j < 4; ++j) {
                        const int s0 = sg * 32 + 8 * g + j, s1 = s0 + 4;
                        if (s0 > t) at0[j] = 0.f;
                        if (s1 > t) at1[j] = 0.f;
                    }
                }
                pf[sg] = pack8(at0, at1);
            }
            f32x4 ot[4];
#pragma unroll
            for (int vi = 0; vi < 4; ++vi) {
                const int vrow = vh * 64 + 32 * (vi >> 1) + 8 * (fr >> 2) + 4 * (vi & 1) + (fr & 3);
                f32x4 o = (f32x4){0.f, 0.f, 0.f, 0.f};
#pragma unroll
                for (int sg = 0; sg < 2; ++sg) {
                    if (sg * 32 <= nt * 16 + 15) {
                        const bf16x8 vf = *(const LAS bf16x8*)(VTs + vrow * 72 + sg * 32 + 8 * g);
                        o = MFMA16(vf, pf[sg], o);
                    }
                }
#pragma unroll
                for (int ks = 0; ks < 4; ++ks) {
                    const bf16x8 sf = *(const LAS bf16x8*)(STs + vrow * 136 + ks * 32 + 8 * g);
                    o = MFMA16(sf, qf[ks], o);
                }
                ot[vi] = o;
            }
            float ssq = 0.f;
#pragma unroll
            for (int vi = 0; vi < 4; ++vi) { const f32x4 o = ot[vi]; ssq += (o.x * o.x + o.y * o.y) + (o.z * o.z + o.w * o.w); }
            ssq += __shfl_xor(ssq, 16); ssq += __shfl_xor(ssq, 32);
            if (g == 0) red[vh * 64 + nt * 16 + fr] = ssq;
            __syncthreads();
            const int t = nt * 16 + fr;
            const float tot = red[t] + red[64 + t];
            const float rs = rsqrtf(tot * (1.0f / 128.0f) + NORM_EPS);
            const size_t row = row0 + t;
#pragma unroll
            for (int pp = 0; pp < 2; ++pp) {
                const int v0 = h * 128 + vh * 64 + 32 * pp + 8 * g;
                const f32x4 g0 = gvv[2 * pp], g1 = gvv[2 * pp + 1]; const u32x4 sg = sgv[pp];
                const f32x4 o0 = ot[2 * pp], o1 = ot[2 * pp + 1];
                u32x4 w;
                w.x = pk2(o0.x * rs * g0.x * bflo(sg.x), o0.y * rs * g0.y * bfhi(sg.x)); w.y = pk2(o0.z * rs * g0.z * bflo(sg.y), o0.w * rs * g0.w * bfhi(sg.y));
                w.z = pk2(o1.x * rs * g1.x * bflo(sg.z), o1.y * rs * g1.y * bfhi(sg.z)); w.w = pk2(o1.z * rs * g1.z * bflo(sg.w), o1.w * rs * g1.w * bfhi(sg.w));
                *(u32x4*)(MIX + row * DM + 512 + v0) = w;
            }
        }
        if (!more) return nu;
        unit = nu - lo;
    }
#undef HG_LOAD_RAW
#undef HG_LOAD_ST
}

__device__ __forceinline__ void hgrn_scan(const Params& P, LAS unsigned char* lds, int layer, int unit) {
    int tid = threadIdx.x; asm volatile("" : "+v"(tid));
    const int bh = unit >> 3, prt = unit & 7;
    const int v = prt * 16 + (tid >> 5), d0 = (tid & 31) * 4;
    const bf16_t* UT = (const bf16_t*)(P.ws + WS_U) + (size_t)bh * 32 * 16384 + v * 128 + d0;
    bf16_t* ST = (bf16_t*)(P.ws + WS_ST) + (size_t)bh * 32 * 16384 + v * 128 + d0;
    const float* DV = (const float*)(P.ws + WS_DV) + (size_t)bh * 32 * 256;
    LAS float* DVs = (LAS float*)lds;
    u32x2 Uw[32];
#pragma unroll
    for (int c = 0; c < 32; ++c) Uw[c] = *(const u32x2*)(UT + (size_t)c * 16384);
    f32x4 dvr[4];
#pragma unroll
    for (int k = 0; k < 4; ++k) dvr[k] = *(const f32x4*)(DV + (size_t)(tid + 512 * k) * 4);
    __syncthreads();
#pragma unroll
    for (int k = 0; k < 4; ++k) *(LAS f32x4*)(DVs + (tid + 512 * k) * 4) = dvr[k];
    __syncthreads();
    f32x4 S = (f32x4){0.f, 0.f, 0.f, 0.f};
#pragma unroll
    for (int c = 0; c < 32; ++c) {
        const f32x4 Dv = *(const LAS f32x4*)(DVs + c * 256 + d0), Ev = *(const LAS f32x4*)(DVs + c * 256 + 128 + d0);
        const f32x4 sp = S * Ev;
        u32x2 w; w.x = pk2(sp.x, sp.y); w.y = pk2(sp.z, sp.w);
        *(u32x2*)(ST + (size_t)c * 16384) = w;
        S = S * Dv + (f32x4){bflo(Uw[c].x), bfhi(Uw[c].x), bflo(Uw[c].y), bfhi(Uw[c].y)};
    }
    float* So = P.out + O_SP + ((size_t)layer * 32 + bh) * 16384;
    So[(size_t)(d0 + 0) * 128 + v] = S.x; So[(size_t)(d0 + 1) * 128 + v] = S.y; So[(size_t)(d0 + 2) * 128 + v] = S.z; So[(size_t)(d0 + 3) * 128 + v] = S.w;
}

__device__ __forceinline__ int first_at_least(int blk, int G, int lo) { int u = blk; if (u < lo) u += ((lo - u + G - 1) / G) * G; return u; }
__device__ __forceinline__ void mixer_pass(const Params& P, LAS unsigned char* lds, int layer, int pass) {
    int G = gridDim.x, blk = blockIdx.x; asm volatile("" : "+s"(G), "+s"(blk));
    unsigned* ctr = (unsigned*)(P.ws + WS_BAR) + 3584 + 16 * (layer * 3 + pass);
    LAS unsigned* slot = (LAS unsigned*)(lds + 131072 + 64);
    const int nx = (pass > 0 && G >= 64) ? 16 : 0;
    const int qbase = G - nx;
    const int n = pass == 0 ? 1664 : (pass == 1 ? 496 : 1040);
    const int tid = threadIdx.x;
    int u;
    if (blk >= nx) u = blk - nx;
    else {
        __syncthreads();
        if (tid == 0) slot[0] = (unsigned)qbase + __hip_atomic_fetch_add(ctr, 1u, __ATOMIC_RELAXED, __HIP_MEMORY_SCOPE_AGENT);
        __syncthreads();
        u = (int)slot[0];
    }
#pragma unroll 1
    while (u < n) {
        if (pass == 0 && u >= 640) { u = hgrn_chunk_loop<0>(P, lds, layer, u, 640, 1664, ctr, qbase, slot); continue; }
        if (pass == 2 && u >= 16) { u = hgrn_chunk_loop<1>(P, lds, layer, u, 16, 1040, ctr, qbase, slot); continue; }
        __syncthreads();
        unsigned popped = 0u;
        if (tid == 0) popped = __hip_atomic_fetch_add(ctr, 1u, __ATOMIC_RELAXED, __HIP_MEMORY_SCOPE_AGENT);
        if (pass == 0) { if (u >= 128) { _Pragma("unroll 1") for (int r = 0; r < DUP_HS; ++r) hgrn_unit<true>(P, lds, layer, u - 128); } else attn_unit<1, 1, true>(P, lds, layer, u); }
        else if (pass == 1) { if (u < 240) { _Pragma("unroll 1") for (int r = 0; r < DUP_ATTN; ++r) attn_unit<2, 2, false>(P, lds, layer, u); } else { _Pragma("unroll 1") for (int r = 0; r < DUP_SCAN; ++r) hgrn_scan(P, lds, layer, u - 240); } }
        else { _Pragma("unroll 1") for (int r = 0; r < DUP_ATTN; ++r) attn_unit<2, 2, false>(P, lds, layer, 240 + u); }
        if (tid == 0) slot[0] = (unsigned)qbase + popped;
        __syncthreads();
        u = (int)slot[0];
    }
}

#define XB_TMO      128
#define XB_XCNT(j)  (256  + 64 * (j))
#define XB_XSUB(j)  (1280 + 64 * (j))
#define XB_XGEN(j)  (2304 + 64 * (j))
#define XB_TOP      3328
#define XB_TOPGEN   3392
#define XCD_BAR_WORDS 3456
#define XB_SPIN_CAP (1u << 20)
__device__ __forceinline__ unsigned xb_ld(unsigned* p)              { return __hip_atomic_load(p, __ATOMIC_RELAXED, __HIP_MEMORY_SCOPE_AGENT); }
__device__ __forceinline__ unsigned xb_add(unsigned* p, unsigned v) { return __hip_atomic_fetch_add(p, v, __ATOMIC_RELAXED, __HIP_MEMORY_SCOPE_AGENT); }
__device__ __forceinline__ unsigned xb_xcc_id() { return (unsigned)__builtin_amdgcn_s_getreg((3 << 11) | 20) & 0xFu; }
#define XB_SPIN(cond, bar) do { unsigned _sp = 0; while (cond) { __builtin_amdgcn_s_sleep(1); \
    if ((++_sp & 255u) == 0u) { if (xb_ld(&(bar)[XB_TMO])) break; if (_sp > XB_SPIN_CAP) { atomicAdd(&(bar)[XB_TMO], 1u); break; } } } } while (0)
struct XcdBarrier { unsigned* bar; unsigned x; volatile LAS unsigned* st; };
__device__ __forceinline__ XcdBarrier xcd_barrier_post(unsigned* bar, volatile LAS unsigned* st) {
    XcdBarrier b; b.bar = bar; b.x = xb_xcc_id(); b.st = st;
    if (threadIdx.x == 0) (void)xb_add(&bar[XB_XCNT(b.x)], 1u);
    return b;
}
__device__ __forceinline__ void xcd_barrier_complete(unsigned* bar, unsigned x, unsigned& nloc, unsigned& nx) {
    const unsigned G = gridDim.x * gridDim.y * gridDim.z;
    unsigned sum, cnt, mine, sp = 0u;
    for (;;) {
        sum = 0u; cnt = 0u; mine = 0u;
#pragma unroll
        for (unsigned j = 0; j < 16; ++j) { const unsigned c = xb_ld(&bar[XB_XCNT(j)]); sum += c; cnt += (c > 0u) ? 1u : 0u; mine = (j == x) ? c : mine; }
        if (sum == G) break;
        __builtin_amdgcn_s_sleep(1);
        if ((++sp & 255u) == 0u) { if (xb_ld(&bar[XB_TMO])) break; if (sp > XB_SPIN_CAP) { atomicAdd(&bar[XB_TMO], 1u); break; } }
    }
    nloc = mine > 0u ? mine : 1u; nx = cnt > 0u ? cnt : 1u;
}
__device__ __forceinline__ void xcd_barrier(const XcdBarrier& b) {
    asm volatile("s_waitcnt vmcnt(0)" ::: "memory");
    __syncthreads();
    if (threadIdx.x == 0) {
        unsigned* bar = b.bar;
        __builtin_amdgcn_s_waitcnt(0);
        unsigned nloc = b.st[0], nx = b.st[1];
        if (nloc == 0u) { xcd_barrier_complete(bar, b.x, nloc, nx); b.st[0] = nloc; b.st[1] = nx; }
        const unsigned old = xb_add(&bar[XB_XSUB(b.x)], 1u);
        const unsigned gen = old / nloc;
        if (old + 1u == (gen + 1u) * nloc) {
            __builtin_amdgcn_fence(__ATOMIC_RELEASE, "agent");
            asm volatile("s_waitcnt vmcnt(0)" ::: "memory");
            const unsigned og = xb_add(&bar[XB_TOP], 1u);
            const unsigned tg = og / nx;
            if (og + 1u == (tg + 1u) * nx) xb_add(&bar[XB_TOPGEN], 1u);
            else XB_SPIN(xb_ld(&bar[XB_TOPGEN]) == tg, bar);
            __builtin_amdgcn_fence(__ATOMIC_ACQUIRE, "agent");
            xb_add(&bar[XB_XGEN(b.x)], 1u);
            asm volatile("s_waitcnt vmcnt(0)" ::: "memory");
        } else {
            XB_SPIN(xb_ld(&bar[XB_XGEN(b.x)]) == gen, bar);
            __builtin_amdgcn_fence(__ATOMIC_ACQUIRE, "agent");
            asm volatile("s_waitcnt vmcnt(0)" ::: "memory");
        }
    }
    __syncthreads();
}

#define GSYNC() do { _Pragma("unroll 1") for (int _r = 0; _r < DUP_SYNC; ++_r) xcd_barrier(xb); } while (0)
__global__ void __launch_bounds__(512, 2) fwd_megakernel(Params P) {
    extern __shared__ __attribute__((aligned(16))) unsigned char shm[];
    LAS unsigned char* lds = (LAS unsigned char*)shm;
    cg::grid_group grid = cg::this_grid();
    if (threadIdx.x < 4) ((LAS unsigned*)(lds + 131072))[threadIdx.x] = 0u;
    __syncthreads();
    XcdBarrier xb = xcd_barrier_post((unsigned*)(P.ws + WS_BAR), (volatile LAS unsigned*)(lds + 131072));
    if (P.out == nullptr) grid.sync();
#pragma unroll 1
    for (int rep = 0; rep < DUP_PRO; ++rep) { prologue(P, lds); __syncthreads(); }
    GSYNC();
    if (blockIdx.x == gridDim.x - 1) {
        const float* cp = (const float*)(P.ws + WS_CP);
        for (int idx = threadIdx.x; idx < 8192; idx += 512) {
            const int l = idx >> 11, which = (idx >> 10) & 1, n = idx & 1023;
            float a = 0.f;
#pragma unroll
            for (int kb = 0; kb < 16; ++kb) a += cp[(size_t)l * 32768 + kb * 2048 + which * 1024 + n];
            ((float*)(P.ws + (which ? WS_C2 : WS_C1)))[l * 1024 + n] = a;
        }
    }
#pragma unroll 1
    for (int l = 0; l < NLAYER; ++l) {
#pragma unroll 1
        for (int stg = 0; stg < 6; ++stg) {
            int G = gridDim.x, blk = blockIdx.x; asm volatile("" : "+s"(G), "+s"(blk));
            const int nx = G >= 64 ? 16 : 0;
#pragma unroll 1
            for (int rep = 0; rep <= ((DUP_STG >> stg) & 1); ++rep) {
            if (rep) __syncthreads();
            if (stg == 0) {
                pg8::Gemm g{(const bf16_t*)(P.ws + WS_XB), (const bf16_t*)(P.ws + WS_WIN) + (size_t)l * INC * 1024, R, INC, 1024};
                pg8::StaticOrder S; S.init(R, INC, G, blk);
                EpiIn E{(bf16_t*)(P.ws + WS_Z), (const float*)(P.ws + WS_COS), (const float*)(P.ws + WS_SIN), (const float*)(P.ws + WS_LB) + l * 512,
                        P.out + O_KP + (size_t)l * 8 * 128 * 128, P.out + O_VP + (size_t)l * 8 * 128 * 128,
                        P.out + O_KS + (size_t)l * 128 * 128 * 128, P.out + O_VS + (size_t)l * 128 * 128 * 128};
                pg8::gemm_phase(lds, g, S, E);
                const int rem = 884 - (884 / G) * G;
                pg8::Gemm g2{(const bf16_t*)(P.ws + WS_PB) + (size_t)l * R * 256, (const bf16_t*)(P.ws + WS_WPP) + (size_t)l * 1024 * 256, R, 1024, 256};
                pg8::StaticOrder S2; S2.init(R, 1024, G - rem, blk >= rem ? blk - rem : (1 << 20));
                EpiPle E2{(bf16_t*)(P.ws + WS_PLE)};
                pg8::gemm_phase(lds, g2, S2, E2);
            }
            if (stg == 2 || stg == 4) {
                const bool smp = (stg == 2);
                const int Mrows = nx ? (smp ? RS : RP) : (smp ? 0 : R);
                const size_t r0 = (nx && smp) ? (size_t)RP : 0;
                pg8::Gemm g{(const bf16_t*)(P.ws + WS_MIX) + r0 * 1024, (const bf16_t*)(P.ws + WS_WOUT) + (size_t)l * 1024 * 1024, Mrows, 1024, 1024};
                pg8::StaticOrder S; S.init(Mrows, 1024, smp ? (nx ? nx : 1) : G, (smp && blk >= nx) ? (1 << 20) : blk);
                EpiOut E{l == 0 ? P.x_prompt : nullptr, l == 0 ? P.x_sample : nullptr, (const bf16_t*)(P.ws + WS_XB),
                         (bf16_t*)(P.ws + WS_PREB), (f32x2*)(P.ws + WS_STAT), (int)(r0 >> 8)};
                pg8::gemm_phase(lds, g, S, E);
            }
            if (stg == 3 || stg == 5) {
                const bool smp = (stg == 3);
                const int Mrows = nx ? (smp ? RS : RP) : (smp ? 0 : R);
                const size_t r0 = (nx && smp) ? (size_t)RP : 0;
                pg8::Gemm g{(const bf16_t*)(P.ws + WS_PREB) + r0 * 1024, (const bf16_t*)(P.ws + WS_WPG) + (size_t)l * 1024 * 1024, Mrows, 1024, 1024};
                pg8::StaticOrder S; S.init(Mrows, 1024, smp ? (nx ? nx : 1) : G, (smp && blk >= nx) ? (1 << 20) : blk);
                EpiGate E{(const bf16_t*)(P.ws + WS_PREB), (const f32x2*)(P.ws + WS_STAT), (const bf16_t*)(P.ws + WS_PLE),
                          (const float*)(P.ws + WS_C1) + l * 1024, (const float*)(P.ws + WS_C2) + l * 1024, P.ln_g + l * 1024, P.ln_b + l * 1024,
                          l == NLAYER - 1 ? P.out + O_Y : nullptr, l == NLAYER - 1 ? (bf16_t*)nullptr : (bf16_t*)(P.ws + WS_XB), (LAS f32x2*)(lds + 131072 + 1024), (int)(r0 >> 8)};
                pg8::gemm_phase(lds, g, S, E);
            }
            if (stg >= 1 && stg <= 3) mixer_pass(P, lds, l, stg - 1);
            }
            if (!(l == NLAYER - 1 && stg == 5)) GSYNC();
        }
    }
}

extern "C" void kernel_launch(void* const* d_in, const int* in_sizes, int n_in, void* d_out, int out_size, void* d_ws, size_t ws_size, hipStream_t stream) {
    static int grid = 0;
    if (grid == 0) {
        if (n_in != 17 || ws_size < WS_END) { fprintf(stderr, "kernel_launch: unexpected n_in %d or ws %zu < %zu\n", n_in, ws_size, (size_t)WS_END); grid = -1; return; }
        int dev = 0, cus = 0, per_cu = 0;
        hipGetDevice(&dev);
        hipDeviceGetAttribute(&cus, hipDeviceAttributeMultiprocessorCount, dev);
        if (hipFuncSetAttribute((const void*)fwd_megakernel, hipFuncAttributeMaxDynamicSharedMemorySize, LDS_BYTES) != hipSuccess) { fprintf(stderr, "kernel_launch: hipFuncSetAttribute failed\n"); grid = -1; return; }
        if (hipOccupancyMaxActiveBlocksPerMultiprocessor(&per_cu, (const void*)fwd_megakernel, 512, LDS_BYTES) != hipSuccess || per_cu < 1) { fprintf(stderr, "kernel_launch: occupancy query says %d\n", per_cu); (void)hipGetLastError(); per_cu = 1; }
        grid = cus * 1;
    }
    if (grid < 0) return;
    Params p{};
    p.x_prompt = (const float*)d_in[0]; p.x_sample = (const float*)d_in[1]; p.cache_k = (const float*)d_in[2]; p.cache_v = (const float*)d_in[3];
    p.state = (const float*)d_in[4]; p.p_prompt = (const float*)d_in[5]; p.p_sample = (const float*)d_in[6]; p.w_in = (const float*)d_in[7];
    p.sinks = (const float*)d_in[8]; p.attn_g = (const float*)d_in[9]; p.lb_logits = (const float*)d_in[10]; p.hg_g = (const float*)d_in[11];
    p.w_out = (const float*)d_in[12]; p.ln_g = (const float*)d_in[13]; p.ln_b = (const float*)d_in[14]; p.w_pp = (const float*)d_in[15]; p.w_pg = (const float*)d_in[16];
    p.out = (float*)d_out; p.ws = (unsigned char*)d_ws;
    if (hipMemsetAsync((char*)d_ws + WS_BAR, 0, 16384, stream) != hipSuccess) { fprintf(stderr, "kernel_launch: hipMemsetAsync failed\n"); return; }
    void* args[] = {&p};
    hipError_t e = hipLaunchCooperativeKernel((const void*)fwd_megakernel, dim3(grid), dim3(512), args, LDS_BYTES, stream);
    if (e != hipSuccess) fprintf(stderr, "cooperative launch failed: %s (grid %d)\n", hipGetErrorString(e), grid);
}
```
